# Optimizing an MI355X kernel written in HIP

```python
import math
import jax, jax.numpy as jnp
from jax import lax
import numpy as np

D_MODEL = 4096
BATCH = 4
SEQ = 4096
DEPTH = 1

CHUNK = 64
Q_BLOCK = 128
A_HEADS = 16
A_HEAD_DIM = 128
A_KV_DIM = 128
IDX_HEADS = 32
IDX_DIM = 128
TOPK_MAX = 256
B_HEADS = 16
Q_LORA = 1024
KV_LORA = 512
QK_NOPE = 128
QK_ROPE = 64
V_DIM = 128
ROPE_THETA = 10000.0
D_FF = 4 * D_MODEL
EPS = 1e-6

A_WIDTH = A_HEADS * A_HEAD_DIM
B_WIDTH = B_HEADS * V_DIM
MIX_WIDTH = A_WIDTH + B_WIDTH
IN_SPLITS = (A_WIDTH, A_KV_DIM, A_KV_DIM, IDX_HEADS * IDX_DIM, IDX_DIM, IDX_HEADS, Q_LORA, KV_LORA, QK_ROPE)
IN_WIDTH = A_WIDTH + 2 * A_KV_DIM + IDX_HEADS * IDX_DIM + IDX_DIM + IDX_HEADS + Q_LORA + KV_LORA + QK_ROPE

kernel_name = 'hybrid_dsa_mla_sqrelu_adaln_block'


def rmsnorm(x, g):
    xf = x.astype(jnp.float32)
    y = xf * lax.rsqrt(jnp.mean(xf * xf, axis=-1, keepdims=True) + EPS)
    return (y * g.astype(jnp.float32)).astype(x.dtype)


def alibi_slopes():
    return 2.0 ** (-8.0 * jnp.arange(1, A_HEADS + 1, dtype=jnp.float32) / A_HEADS)


def rope_tables(pos):
    inv = ROPE_THETA ** (-jnp.arange(0, QK_ROPE, 2, dtype=jnp.float32) / QK_ROPE)
    ang = pos.astype(jnp.float32)[..., None] * inv
    return jnp.cos(ang), jnp.sin(ang)


def apply_rope(x, cos, sin):
    x1, x2 = jnp.split(x.astype(jnp.float32), 2, axis=-1)
    out = jnp.concatenate([x1 * cos - x2 * sin, x1 * sin + x2 * cos], axis=-1)
    return out.astype(x.dtype)


def to_blocks(a):
    b, s = a.shape[0], a.shape[1]
    a = a.reshape((b, s // Q_BLOCK, Q_BLOCK) + a.shape[2:])
    return jnp.moveaxis(a, 1, 0)


def from_blocks(a):
    a = jnp.moveaxis(a, 0, 1)
    return a.reshape((a.shape[0], a.shape[1] * a.shape[2]) + a.shape[3:])


def sparse_indexer_attention(q, k, v, q_idx, k_idx, w_idx, pos):
    b, s = pos.shape
    topk = min(TOPK_MAX, s // 4)
    chunk_k = pos // CHUNK
    slopes = alibi_slopes()

    def block(xs):
        qb, qib, wb, pb = xs
        admissible = chunk_k[:, None, :] <= (pb // CHUNK)[:, :, None]
        logits = jnp.einsum('bqhd,bsd->bqhs', qib, k_idx).astype(jnp.float32) * (IDX_DIM ** -0.5)
        wts = wb.astype(jnp.float32) * (IDX_HEADS ** -0.5)
        score = jnp.einsum('bqh,bqhs->bqs', wts, jax.nn.relu(logits))
        score = jnp.where(admissible, score, -jnp.inf)
        vals, idx = lax.top_k(score, topk)
        valid = jnp.isfinite(vals)
        flat = idx.reshape(b, -1)
        k_sel = jnp.take_along_axis(k, flat[..., None], axis=1).reshape(b, Q_BLOCK, topk, A_KV_DIM)
        v_sel = jnp.take_along_axis(v, flat[..., None], axis=1).reshape(b, Q_BLOCK, topk, A_KV_DIM)
        p_sel = jnp.take_along_axis(pos, flat, axis=1).reshape(b, Q_BLOCK, topk)
        dist = jnp.abs(pb[:, :, None] - p_sel).astype(jnp.float32)
        sc = jnp.einsum('bqhd,bqkd->bhqk', qb, k_sel).astype(jnp.float32) * (A_HEAD_DIM ** -0.5)
        sc = sc - slopes[None, :, None, None] * dist[:, None]
        sc = jnp.where(valid[:, None], sc, -jnp.inf)
        p = jax.nn.softmax(sc, axis=-1).astype(v.dtype)
        return jnp.einsum('bhqk,bqkd->bqhd', p, v_sel)

    out = lax.map(block, (to_blocks(q), to_blocks(q_idx), to_blocks(w_idx), to_blocks(pos)))
    return from_blocks(out)


def mla_attention(q_nope, q_rope, k_nope, k_rope, v, pos):
    chunk_k = pos // CHUNK
    scale = (QK_NOPE + QK_ROPE) ** -0.5

    def block(xs):
        qn, qr, pb = xs
        admissible = chunk_k[:, None, :] <= (pb // CHUNK)[:, :, None]
        sc = jnp.einsum('bqhd,bshd->bhqs', qn, k_nope) + jnp.einsum('bqhr,bsr->bhqs', qr, k_rope)
        sc = jnp.where(admissible[:, None], sc.astype(jnp.float32) * scale, -jnp.inf)
        p = jax.nn.softmax(sc, axis=-1).astype(v.dtype)
        return jnp.einsum('bhqs,bshd->bqhd', p, v)

    out = lax.map(block, (to_blocks(q_nope), to_blocks(q_rope), to_blocks(pos)))
    return from_blocks(out)


def setup_inputs(seed: int = 0) -> dict:
    key = jax.random.key(seed)
    ks = jax.random.split(key, 20)
    f32 = jnp.float32

    def nrm(k, shape, scale):
        return jax.random.normal(k, shape, f32) * scale

    def gain(k, shape):
        return 1.0 + 0.1 * jax.random.normal(k, shape, f32)

    offsets = jax.random.randint(ks[2], (BATCH,), 0, 16) * CHUNK
    positions = (offsets[:, None] + jnp.arange(SEQ, dtype=jnp.int32)[None, :]).astype(jnp.int32)
    return {
        'x': nrm(ks[0], (BATCH, SEQ, D_MODEL), 1.0),
        'c': nrm(ks[1], (BATCH, D_MODEL), 1.0),
        'positions': positions,
        'w_ada': nrm(ks[3], (DEPTH, D_MODEL, 6 * D_MODEL), 0.3 * D_MODEL ** -0.5),
        'b_ada': nrm(ks[4], (DEPTH, 6 * D_MODEL), 0.1),
        'ln1_g': gain(ks[5], (DEPTH, D_MODEL)),
        'w_in': nrm(ks[6], (DEPTH, D_MODEL, IN_WIDTH), D_MODEL ** -0.5),
        'q_norm_g': gain(ks[7], (DEPTH, Q_LORA)),
        'kv_norm_g': gain(ks[8], (DEPTH, KV_LORA)),
        'w_uq': nrm(ks[9], (DEPTH, Q_LORA, B_HEADS * (QK_NOPE + QK_ROPE)), Q_LORA ** -0.5),
        'w_uk': nrm(ks[10], (DEPTH, KV_LORA, B_HEADS * QK_NOPE), KV_LORA ** -0.5),
        'w_uv': nrm(ks[11], (DEPTH, KV_LORA, B_HEADS * V_DIM), KV_LORA ** -0.5),
        'w_o': nrm(ks[12], (DEPTH, MIX_WIDTH, D_MODEL), MIX_WIDTH ** -0.5),
        'ln2_g': gain(ks[13], (DEPTH, D_MODEL)),
        'w_mlp_in': nrm(ks[14], (DEPTH, D_MODEL, D_FF), D_MODEL ** -0.5),
        'w_mlp_out': nrm(ks[15], (DEPTH, D_FF, D_MODEL), D_FF ** -0.5),
        'final_g': gain(ks[16], (D_MODEL,)),
    }


def reference(x, c, positions, w_ada, b_ada, ln1_g, w_in, q_norm_g, kv_norm_g, w_uq, w_uk, w_uv,
              w_o, ln2_g, w_mlp_in, w_mlp_out, final_g):
    b, s, _ = x.shape
    split_points = np.cumsum(IN_SPLITS)[:-1].tolist()
    cos, sin = rope_tables(positions)
    for l in range(DEPTH):
        mod = jnp.einsum('bd,de->be', jax.nn.silu(c), w_ada[l]) + b_ada[l]
        shift1, scale1, gate1, shift2, scale2, gate2 = jnp.split(mod, 6, axis=-1)

        h = rmsnorm(x, ln1_g[l]) * (1.0 + scale1[:, None]) + shift1[:, None]
        proj = jnp.einsum('bsd,de->bse', h, w_in[l])
        q_a, k_a, v_a, q_i, k_i, w_i, c_q, c_kv, k_r = jnp.split(proj, split_points, axis=-1)

        out_a = sparse_indexer_attention(
            q_a.reshape(b, s, A_HEADS, A_HEAD_DIM), k_a, v_a,
            q_i.reshape(b, s, IDX_HEADS, IDX_DIM), k_i, w_i, positions)

        q_full = jnp.einsum('bsr,re->bse', rmsnorm(c_q, q_norm_g[l]), w_uq[l])
        q_full = q_full.reshape(b, s, B_HEADS, QK_NOPE + QK_ROPE)
        q_nope, q_rope = q_full[..., :QK_NOPE], q_full[..., QK_NOPE:]
        q_rope = apply_rope(q_rope, cos[:, :, None], sin[:, :, None])
        kv_lat = rmsnorm(c_kv, kv_norm_g[l])
        k_nope = jnp.einsum('bsr,re->bse', kv_lat, w_uk[l]).reshape(b, s, B_HEADS, QK_NOPE)
        v_b = jnp.einsum('bsr,re->bse', kv_lat, w_uv[l]).reshape(b, s, B_HEADS, V_DIM)
        k_rope = apply_rope(k_r, cos, sin)
        out_b = mla_attention(q_nope, q_rope, k_nope, k_rope, v_b, positions)

        mix = jnp.concatenate([out_a.reshape(b, s, A_WIDTH), out_b.reshape(b, s, B_WIDTH)], axis=-1)
        x = x + gate1[:, None] * jnp.einsum('bse,ed->bsd', mix, w_o[l])

        h2 = rmsnorm(x, ln2_g[l]) * (1.0 + scale2[:, None]) + shift2[:, None]
        hid = jnp.square(jax.nn.relu(jnp.einsum('bsd,df->bsf', h2, w_mlp_in[l])))
        x = x + gate2[:, None] * jnp.einsum('bsf,fd->bsd', hid, w_mlp_out[l])
    return rmsnorm(x, final_g)
```

```cpp
#include <hip/hip_runtime.h>
#include <cstdio>
#include <cstdint>

#ifndef MK_PER_PHASE
#define MK_PER_PHASE 0
#endif

#define DEV __device__ __forceinline__
#define LAS __attribute__((address_space(3)))
#define GAS __attribute__((address_space(1)))
typedef unsigned short bf16;
typedef short bf16x8 __attribute__((ext_vector_type(8)));
typedef short s16x4 __attribute__((ext_vector_type(4)));
typedef float f32x4 __attribute__((ext_vector_type(4)));
typedef float f32x2 __attribute__((ext_vector_type(2)));
typedef float f32x16 __attribute__((ext_vector_type(16)));
typedef unsigned u32x4 __attribute__((ext_vector_type(4)));
typedef unsigned u32x2 __attribute__((ext_vector_type(2)));
typedef int i32x4 __attribute__((ext_vector_type(4)));

constexpr int NB = 4, SEQ = 4096, DM = 4096, M = NB * SEQ;
constexpr int INW = 8160, INP = 8192;
constexpr int C_QA = 0, C_KA = 2048, C_VA = 2176, C_QI = 2304, C_KI = 6400, C_WI = 6528, C_CQ = 6560, C_CKV = 7584, C_KR = 8096;
constexpr int NA = 5120, NBQ = 3072;
constexpr int A_QI = 0, A_KI = 4096, A_WI = 4224, A_KA = 4256, A_VA = 4384, A_CKV = 4512, A_KR = 5024, A_END = 5088;
constexpr int B_QA = 0, B_CQ = 2048;
constexpr int QLORA = 1024, KVLORA = 512, NQF = 3072, NKV = 4096, DFF = 16384;
constexpr int TOPK = 256;
constexpr float EPS = 1e-6f;

constexpr size_t MiB = 1u << 20;
constexpr size_t WS_CTL = 0, CTL_ZERO_BYTES = 1 * MiB;
constexpr size_t WS_MODP = 2 * MiB;
constexpr size_t WS_GATE = 3 * MiB;
constexpr size_t WS_RSQ = 3 * MiB + 256 * 1024;
constexpr size_t WS_RSKV = 3 * MiB + 512 * 1024;
constexpr size_t WS_CK = 3 * MiB + 768 * 1024;
constexpr size_t WS_TMM = 4 * MiB - 8192;
constexpr size_t WS_CNT = 4 * MiB;
constexpr size_t WS_RSA = 4 * MiB + 256 * 1024;
constexpr size_t WS_CSB = 4 * MiB + 384 * 1024;
constexpr size_t WS_CMAXP = 4 * MiB + 448 * 1024;
constexpr size_t WS_CSU = 4 * MiB + 576 * 1024;
constexpr size_t WS_CMAXU = 4 * MiB + 640 * 1024;
constexpr size_t WS_CQ8 = 1002 * MiB, WS_CKV8 = 1018 * MiB;
constexpr size_t WS_COS = 5 * MiB, WS_SIN = 7 * MiB;
constexpr size_t WS_KROPE = 9 * MiB;
constexpr size_t WS_KROPE8 = 12 * MiB;
constexpr size_t WS_IDX = 16 * MiB;
constexpr size_t WS_WIN = 32 * MiB;
constexpr size_t WS_WUQ = 96 * MiB;
constexpr size_t WS_WUKV = 102 * MiB;
constexpr size_t WS_WO = 106 * MiB;
constexpr size_t WS_WUP = 138 * MiB;
constexpr size_t WS_WDN = 266 * MiB;
constexpr size_t WS_H = 394 * MiB;
constexpr size_t WS_PROJ = 522 * MiB;
constexpr size_t WS_PA = WS_PROJ, WS_PB = WS_PROJ + 160 * MiB;
constexpr size_t WS_WINB = 32 * MiB + 40 * MiB;
constexpr size_t WS_QF = 778 * MiB;
constexpr size_t WS_X1 = 874 * MiB;
constexpr size_t WS_X2 = 1130 * MiB;
constexpr size_t WS_H8 = WS_QF;
constexpr size_t WS_KAV8 = 940 * MiB;
constexpr size_t WS_KV = 874 * MiB;
constexpr size_t WS_MIX = 1002 * MiB;
constexpr size_t WS_SC = 1130 * MiB;
constexpr size_t WS_HID = 522 * MiB;
constexpr size_t WS_END = 1386 * MiB;

constexpr int CW_BAR = 4096;

constexpr int RING_BYTES = 131072;
constexpr int MISC_OFF = 140000;
constexpr int LDS_BYTES = 147456;

DEV unsigned f2bf(float f) { unsigned u = __builtin_bit_cast(unsigned, f); return (u + 0x7fffu + ((u >> 16) & 1u)) >> 16; }
DEV unsigned pk2(float lo, float hi) { return f2bf(lo) | (f2bf(hi) << 16); }
DEV float bf2f(unsigned short b) { return __builtin_bit_cast(float, ((unsigned)b) << 16); }
DEV float bflo(unsigned w) { return __builtin_bit_cast(float, w << 16); }
DEV float bfhi(unsigned w) { return __builtin_bit_cast(float, w & 0xffff0000u); }
DEV unsigned cvt_pk_bf16(float lo, float hi) { unsigned r; asm volatile("v_cvt_pk_bf16_f32 %0, %1, %2" : "=v"(r) : "v"(lo), "v"(hi)); return r; }
DEV float wave_sum(float v) {
#pragma unroll
    for (int o = 1; o < 64; o <<= 1) v += __shfl_xor(v, o);
    return v;
}
DEV int wave_max_i(int v) {
#pragma unroll
    for (int o = 1; o < 64; o <<= 1) { int t = __shfl_xor(v, o); v = t > v ? t : v; }
    return v;
}
DEV int wave_min_i(int v) {
#pragma unroll
    for (int o = 1; o < 64; o <<= 1) { int t = __shfl_xor(v, o); v = t < v ? t : v; }
    return v;
}
template <class T> DEV T ldg(const void* base, unsigned byteoff, size_t imm = 0) { return *(const T*)((const char*)base + (size_t)byteoff + imm); }
template <class T> DEV void stg(void* base, unsigned byteoff, size_t imm, T v) { *(T*)((char*)base + (size_t)byteoff + imm) = v; }
DEV unsigned opq(unsigned v) { asm volatile("" : "+v"(v)); return v; }
DEV int floordiv64(int p) { return p >> 6; }
#define LDS_WAIT() asm volatile("s_waitcnt lgkmcnt(0)" ::: "memory")
#define VM_WAIT() asm volatile("s_waitcnt vmcnt(0)" ::: "memory")
#define SBAR() __builtin_amdgcn_sched_barrier(0)

namespace pg8 {
#define PG8_LAS __attribute__((address_space(3)))
constexpr int BM = 256, BK = 64, HALF = 128, HTB = HALF * BK * 2, STAGE_BYTES = 8 * HTB, NXCD = 8, WGM = 8;
__host__ __device__ __forceinline__ int lds_byte(int r, int c) { const int st = (r >> 4) * 2 + (c >> 5), rr = r & 15, cc = c & 31, ob = rr * 64 + cc * 2; return st * 1024 + (ob ^ (((ob >> 9) & 1) << 5)); }
__host__ __device__ __forceinline__ void stage_rc(int b, int& R, int& C) { const int st = b / 1024, sb = b % 1024, swz = sb ^ (((sb >> 9) & 1) << 5); R = (st >> 1) * 16 + swz / 64; C = (st & 1) * 32 + (swz % 64) / 2; }
__host__ __device__ __forceinline__ int perm32(int rho) { const int n = rho >> 4, i = rho & 15; return 8 * (i >> 2) + 4 * n + (i & 3); }
struct Unit { int pm, pn; };
typedef int v8i __attribute__((ext_vector_type(8)));
DEV v8i cat8(bf16x8 lo, bf16x8 hi) { typedef int v4i __attribute__((ext_vector_type(4))); const v4i a = __builtin_bit_cast(v4i, lo), b = __builtin_bit_cast(v4i, hi); return (v8i){a.x, a.y, a.z, a.w, b.x, b.y, b.z, b.w}; }
struct Gemm { const void* A; const void* Bt; int M, N, Kb, lda, ldb; int scaleB; };
struct StaticOrder {
    int nM, nN, nwg, G, c, probe, wgm;
    __host__ __device__ void init(int M_, int N_, int G_, int c_, int wgm_ = 4) { nM = M_ / BM; nN = N_ / BM; nwg = nM * nN; G = G_; c = c_; probe = 0; wgm = wgm_; }
    __host__ __device__ bool next(int i, Unit& u) const {
        const long L = (long)i * G + c; if (L >= nwg) return false;
        if (probe) { u.pm = (c >> 3) & 1; u.pn = 0; return true; }
        int wgid = (int)L; { const int q = nwg / NXCD, r = nwg % NXCD, xcd = wgid % NXCD, off = wgid / NXCD; wgid = (xcd < r ? xcd * (q + 1) : r * (q + 1) + (xcd - r) * q) + off; }
        const int nig = wgm * nN, gid = wgid / nig, fm = gid * wgm, gsz = (nM - fm) < wgm ? (nM - fm) : wgm;
        u.pm = fm + ((wgid % nig) % gsz); u.pn = (wgid % nig) / gsz; return true;
    }
    DEV void a_ready(const Unit&) const {}
    DEV void done(const Unit&) const {}
};
DEV unsigned pk4_fp8(float a, float b, float c, float d) { unsigned w; asm("" : "=v"(w));
    w = __builtin_amdgcn_cvt_pk_fp8_f32(a, b, w, false); w = __builtin_amdgcn_cvt_pk_fp8_f32(c, d, w, true); return w; }
template <int MODE> struct EpiBf16 {
    static constexpr bool PERM = true;
    bf16* O; int ldc; const float* rs; const float* cs; unsigned char* side8 = nullptr;
    DEV void operator()(const f32x4 (&acc)[2][2][4][2], const Unit& u, int, int, int, int) const {
        const unsigned tz = opq(threadIdx.x); const int fr = tz & 15, fq = (tz >> 4) & 3, wc = (tz >> 6) & 3, wr = tz >> 8;
        const int row0 = u.pm * BM + wr * 64 + fr; const int col0 = u.pn * BM + wc * 32 + 8 * fq;
#pragma unroll
        for (int ai = 0; ai < 2; ++ai)
#pragma unroll
            for (int m = 0; m < 4; ++m) { const int row = row0 + ai * HALF + m * 16; bf16* rowp = O + (size_t)row * ldc + col0;
                float sc = 1.f; if (MODE == 1 || MODE == 3 || MODE == 5) sc = rs[row];
#pragma unroll
                for (int bj = 0; bj < 2; ++bj) { f32x4 v0 = acc[ai][bj][m][0], v1 = acc[ai][bj][m][1];
                    if (MODE == 1) { v0 = v0 * sc; v1 = v1 * sc; }
                    if (MODE == 3 || MODE == 5) { const i32x4 i0 = __builtin_bit_cast(i32x4, v0), i1 = __builtin_bit_cast(i32x4, v1); const f32x4 c0 = *(const f32x4*)(cs + col0 + bj * HALF), c1 = *(const f32x4*)(cs + col0 + bj * HALF + 4);
                        v0 = (f32x4){(float)i0.x, (float)i0.y, (float)i0.z, (float)i0.w} * c0 * sc; v1 = (f32x4){(float)i1.x, (float)i1.y, (float)i1.z, (float)i1.w} * c1 * sc; }
                    if (MODE == 2) {
#pragma unroll
                        for (int j = 0; j < 4; ++j) { float a = fmaxf(v0[j], 0.f), b = fmaxf(v1[j], 0.f); v0[j] = a * a; v1[j] = b * b; } }
                    u32x4 w; w.x = cvt_pk_bf16(v0[0], v0[1]); w.y = cvt_pk_bf16(v0[2], v0[3]); w.z = cvt_pk_bf16(v1[0], v1[1]); w.w = cvt_pk_bf16(v1[2], v1[3]);
                    *(u32x4*)(rowp + bj * HALF) = w;
                    if (MODE == 5) { const int c_ = col0 + bj * HALF - A_KA;
                        if ((unsigned)c_ < 256u) { u32x2 w8; w8.x = pk4_fp8(v0[0], v0[1], v0[2], v0[3]); w8.y = pk4_fp8(v1[0], v1[1], v1[2], v1[3]); *(u32x2*)(side8 + (size_t)row * 256 + c_) = w8; } } } }
    }
};
struct EpiFp8Relu2 {
    static constexpr bool PERM = true;
    unsigned char* O; int ldc;
    DEV void operator()(const f32x4 (&acc)[2][2][4][2], const Unit& u, int, int, int, int) const {
        const unsigned tz = opq(threadIdx.x); const int fr = tz & 15, fq = (tz >> 4) & 3, wc = (tz >> 6) & 3, wr = tz >> 8;
        const int row0 = u.pm * BM + wr * 64 + fr; const int col0 = u.pn * BM + wc * 32 + 8 * fq;
#pragma unroll
        for (int ai = 0; ai < 2; ++ai)
#pragma unroll
            for (int m = 0; m < 4; ++m) { unsigned char* rowp = O + (size_t)(row0 + ai * HALF + m * 16) * ldc + col0;
#pragma unroll
                for (int bj = 0; bj < 2; ++bj) { f32x4 v0 = acc[ai][bj][m][0], v1 = acc[ai][bj][m][1];
#pragma unroll
                    for (int j = 0; j < 4; ++j) { const float a = fmaxf(v0[j], 0.f), b = fmaxf(v1[j], 0.f); v0[j] = fminf(a * a, 448.f); v1[j] = fminf(b * b, 448.f); }
                    u32x2 w; w.x = pk4_fp8(v0[0], v0[1], v0[2], v0[3]); w.y = pk4_fp8(v1[0], v1[1], v1[2], v1[3]);
                    *(u32x2*)(rowp + bj * HALF) = w; } }
    }
};
struct EpiFp8Deq {
    static constexpr bool PERM = true;
    unsigned char* O; int ldc; const float* rs; const float* cs;
    DEV void operator()(const f32x4 (&acc)[2][2][4][2], const Unit& u, int, int, int, int) const {
        const unsigned tz = opq(threadIdx.x); const int fr = tz & 15, fq = (tz >> 4) & 3, wc = (tz >> 6) & 3, wr = tz >> 8;
        const int row0 = u.pm * BM + wr * 64 + fr; const int col0 = u.pn * BM + wc * 32 + 8 * fq;
#pragma unroll
        for (int ai = 0; ai < 2; ++ai)
#pragma unroll
            for (int m = 0; m < 4; ++m) { const int row = row0 + ai * HALF + m * 16; unsigned char* rowp = O + (size_t)row * ldc + col0; const float sc = rs[row];
#pragma unroll
                for (int bj = 0; bj < 2; ++bj) { const i32x4 i0 = __builtin_bit_cast(i32x4, acc[ai][bj][m][0]), i1 = __builtin_bit_cast(i32x4, acc[ai][bj][m][1]);
                    const f32x4 c0 = *(const f32x4*)(cs + col0 + bj * HALF), c1 = *(const f32x4*)(cs + col0 + bj * HALF + 4);
                    const f32x4 v0 = (f32x4){(float)i0.x, (float)i0.y, (float)i0.z, (float)i0.w} * c0 * sc, v1 = (f32x4){(float)i1.x, (float)i1.y, (float)i1.z, (float)i1.w} * c1 * sc;
                    u32x2 w; w.x = pk4_fp8(v0[0], v0[1], v0[2], v0[3]); w.y = pk4_fp8(v1[0], v1[1], v1[2], v1[3]);
                    *(u32x2*)(rowp + bj * HALF) = w; } }
    }
};
template <bool BASE_BF16> struct EpiResGate {
    static constexpr bool PERM = true;
    const void* base; bf16* out; int ldc; const float* gate;
    DEV void operator()(const f32x4 (&acc)[2][2][4][2], const Unit& u, int, int, int, int) const {
        const unsigned tz = opq(threadIdx.x); const int fr = tz & 15, fq = (tz >> 4) & 3, wc = (tz >> 6) & 3, wr = tz >> 8;
        const int row0 = u.pm * BM + wr * 64 + fr, col0 = u.pn * BM + wc * 32 + 8 * fq;
        const float* gp = gate + (size_t)((u.pm * BM) / SEQ) * ldc + col0;
#pragma unroll
        for (int ai = 0; ai < 2; ++ai)
#pragma unroll
            for (int m = 0; m < 4; ++m) { const size_t off = (size_t)(row0 + ai * HALF + m * 16) * ldc + col0;
#pragma unroll
                for (int bj = 0; bj < 2; ++bj) { f32x4 b0, b1; f32x4 gv[2][2]; gv[bj][0] = *(const f32x4*)(gp + bj * HALF); gv[bj][1] = *(const f32x4*)(gp + bj * HALF + 4);
                    if (BASE_BF16) { const u32x4 w = *(const u32x4*)((const bf16*)base + off + bj * HALF); b0 = (f32x4){bflo(w.x), bfhi(w.x), bflo(w.y), bfhi(w.y)}; b1 = (f32x4){bflo(w.z), bfhi(w.z), bflo(w.w), bfhi(w.w)}; }
                    else { b0 = *(const f32x4*)((const float*)base + off + bj * HALF); b1 = *(const f32x4*)((const float*)base + off + bj * HALF + 4); }
                    const f32x4 r0 = b0 + gv[bj][0] * acc[ai][bj][m][0], r1 = b1 + gv[bj][1] * acc[ai][bj][m][1];
                    u32x4 o; o.x = cvt_pk_bf16(r0[0], r0[1]); o.y = cvt_pk_bf16(r0[2], r0[3]); o.z = cvt_pk_bf16(r1[0], r1[1]); o.w = cvt_pk_bf16(r1[2], r1[3]);
                    *(u32x4*)(out + off + bj * HALF) = o; }
                asm volatile("" ::: "memory"); }
    }
};

template <int FP8  , class Epi, class Sched, int SCALEB = 0x7f7f7f7f, bool ALIGN_EPI = true>
DEV void gemm_phase(PG8_LAS unsigned char* lds, const Gemm g, const Sched& S, const Epi& E) {
    const int tid = threadIdx.x, wid = __builtin_amdgcn_readfirstlane(tid >> 6), lane = tid & 63, wr = wid >> 2, wc = wid & 3, fr = lane & 15, fq = lane >> 4;
    const int nt = g.Kb / 128;
    unsigned voffA[2], voffB[2];
#pragma unroll
    for (int i = 0; i < 2; ++i) { int R, C; stage_rc(tid * 16 + i * 8192, R, C); const int Rb = Epi::PERM ? ((R & ~31) + perm32(R & 31)) : R;
        voffA[i] = (unsigned)(R * g.lda + C * 2); voffB[i] = (unsigned)(Rb * g.ldb + C * 2); }
    const size_t kstep = (size_t)(BK * 2);
    const size_t hstepA = (size_t)HALF * g.lda, hstepB = (size_t)HALF * g.ldb;
    const size_t tstepA = 2 * hstepA, tstepB = 2 * hstepB;
    const unsigned ldsw = (unsigned)wid * 1024u;
    const int aoff = lds_byte(wr * 64 + fr, fq * 8), boff = lds_byte(wc * 32 + fr, fq * 8);
#define PG8_SA(b, h) (((b) * 2 + (h)) * HTB)
#define PG8_SB(b, h) ((4 + (b) * 2 + (h)) * HTB)
#define PG8_STAGE(bufoff, gbase, voff) do { _Pragma("unroll") for (int _i = 0; _i < 2; ++_i) \
        __builtin_amdgcn_global_load_lds((const unsigned*)((const char*)(gbase) + (FP8 ? opq((voff)[_i]) : (voff)[_i])), (PG8_LAS unsigned*)(lds + (bufoff) + ldsw + _i * 8192), 16, 0, 0); } while (0)
#define PG8_LDA(dst, b, h) do { _Pragma("unroll") for (int m = 0; m < 4; ++m) _Pragma("unroll") for (int k = 0; k < 2; ++k) dst[m][k] = *(const PG8_LAS bf16x8*)(lds + PG8_SA(b, h) + aoff + m * 2048 + k * 1024); } while (0)
#define PG8_LDB(dst, b, h) do { _Pragma("unroll") for (int n = 0; n < 2; ++n) _Pragma("unroll") for (int k = 0; k < 2; ++k) dst[n][k] = *(const PG8_LAS bf16x8*)(lds + PG8_SB(b, h) + boff + n * 2048 + k * 1024); } while (0)
#define PG8_MMA(ai, bj, At, Bt) do { __builtin_amdgcn_s_setprio(1); _Pragma("unroll") for (int m = 0; m < 4; ++m) _Pragma("unroll") for (int n = 0; n < 2; ++n) { \
        if constexpr (FP8 == 1) { acc[ai][bj][m][n] = __builtin_amdgcn_mfma_scale_f32_16x16x128_f8f6f4(cat8(Bt[n][0], Bt[n][1]), cat8(At[m][0], At[m][1]), acc[ai][bj][m][n], 0, 0, 0, SCALEB, 0, 0x7f7f7f7f); } \
        else if constexpr (FP8 == 3) { _Pragma("unroll") for (int k = 0; k < 2; ++k) acc[ai][bj][m][n] = __builtin_bit_cast(f32x4, __builtin_amdgcn_mfma_i32_16x16x64_i8(__builtin_bit_cast(i32x4, Bt[n][k]), __builtin_bit_cast(i32x4, At[m][k]), __builtin_bit_cast(i32x4, acc[ai][bj][m][n]), 0, 0, 0)); } \
        else { _Pragma("unroll") for (int k = 0; k < 2; ++k) acc[ai][bj][m][n] = __builtin_amdgcn_mfma_f32_16x16x32_bf16(Bt[n][k], At[m][k], acc[ai][bj][m][n], 0, 0, 0); } } \
        __builtin_amdgcn_s_setprio(0); } while (0)
#define PG8_WAIT_V(n) asm volatile("s_waitcnt vmcnt(" #n ")" ::: "memory")
#define PG8_WAIT_L(n) asm volatile("s_waitcnt lgkmcnt(" #n ")" ::: "memory")
#define PG8_BAR __builtin_amdgcn_s_barrier()
#define PG8_SCHED __builtin_amdgcn_sched_barrier(0)
    Unit cur, nxt; int ui = 0;
    if (!S.next(0, cur)) return;
    f32x4 acc[2][2][4][2];
#pragma unroll
    for (int a = 0; a < 2; ++a)
#pragma unroll
        for (int b = 0; b < 2; ++b)
#pragma unroll
            for (int m = 0; m < 4; ++m)
#pragma unroll
                for (int n = 0; n < 2; ++n) acc[a][b][m][n] = (f32x4){0.f, 0.f, 0.f, 0.f};
    bf16x8 At[4][2], B0[2][2], B1[2][2];
    const char* cA = (const char*)g.A + (size_t)cur.pm * tstepA; const char* cB = (const char*)g.Bt + (size_t)cur.pn * tstepB;
    S.a_ready(cur);
    PG8_STAGE(PG8_SB(0, 0), cB, voffB); PG8_STAGE(PG8_SB(0, 1), cB + hstepB, voffB); PG8_STAGE(PG8_SA(0, 0), cA, voffA); PG8_STAGE(PG8_SA(0, 1), cA + hstepA, voffA);
    if (wr == 1) PG8_BAR;
    PG8_WAIT_V(2); PG8_BAR;
    PG8_STAGE(PG8_SB(1, 0), cB + kstep, voffB); PG8_STAGE(PG8_SA(1, 0), cA + kstep, voffA); PG8_STAGE(PG8_SB(1, 1), cB + hstepB + kstep, voffB);
    PG8_WAIT_V(6); PG8_BAR;
    for (;;) {
        const bool has_next = S.next(ui + 1, nxt);
        const char* nA = has_next ? (const char*)g.A + (size_t)nxt.pm * tstepA : cA; const char* nB = has_next ? (const char*)g.Bt + (size_t)nxt.pn * tstepB : cB;
        for (int t = 0; t < nt; t += 2) {
            const bool last = (t == nt - 2);
            const char* a1 = cA + (size_t)(t + 1) * kstep;
            const char* a2 = last ? nA : cA + (size_t)(t + 2) * kstep; const char* b2 = last ? nB : cB + (size_t)(t + 2) * kstep;
            const char* a3 = a2 + kstep; const char* b3 = b2 + kstep;
            if (last && has_next) S.a_ready(nxt);
            PG8_LDB(B0, 0, 0); PG8_LDB(B1, 0, 1); PG8_SCHED; PG8_LDA(At, 0, 0); PG8_STAGE(PG8_SA(1, 1), a1 + hstepA, voffA);
            PG8_WAIT_V(8); PG8_WAIT_L(0); PG8_BAR; PG8_MMA(0, 0, At, B0); PG8_MMA(0, 1, At, B1); PG8_BAR; PG8_SCHED;
            PG8_LDA(At, 0, 1); PG8_STAGE(PG8_SB(0, 0), b2, voffB); PG8_STAGE(PG8_SB(0, 1), b2 + hstepB, voffB); PG8_STAGE(PG8_SA(0, 0), a2, voffA);
            PG8_WAIT_V(8); PG8_WAIT_L(0); PG8_BAR; PG8_MMA(1, 0, At, B0); PG8_MMA(1, 1, At, B1); PG8_BAR; PG8_SCHED;
            PG8_LDB(B0, 1, 0); PG8_LDB(B1, 1, 1); PG8_SCHED; PG8_LDA(At, 1, 0); PG8_STAGE(PG8_SA(0, 1), a2 + hstepA, voffA);
            PG8_WAIT_V(8); PG8_WAIT_L(0); PG8_BAR; PG8_MMA(0, 0, At, B0); PG8_MMA(0, 1, At, B1); PG8_BAR; PG8_SCHED;
            PG8_LDA(At, 1, 1); PG8_STAGE(PG8_SB(1, 0), b3, voffB); PG8_STAGE(PG8_SB(1, 1), b3 + hstepB, voffB); PG8_STAGE(PG8_SA(1, 0), a3, voffA);
            PG8_WAIT_V(8); PG8_WAIT_L(0); PG8_BAR; PG8_MMA(1, 0, At, B0); PG8_MMA(1, 1, At, B1); PG8_BAR; PG8_SCHED;
        }
        if constexpr (ALIGN_EPI) { if (wr == 0) PG8_BAR; }
        E(acc, cur, wr, wc, fr, fq); S.done(cur);
        if (!has_next) break;
#pragma unroll
        for (int a = 0; a < 2; ++a)
#pragma unroll
            for (int b = 0; b < 2; ++b)
#pragma unroll
                for (int m = 0; m < 4; ++m)
#pragma unroll
                    for (int n = 0; n < 2; ++n) acc[a][b][m][n] = (f32x4){0.f, 0.f, 0.f, 0.f};
        cur = nxt; cA = nA; cB = nB; ++ui;
        if constexpr (ALIGN_EPI) { if (wr == 1) PG8_BAR; }
    }
    PG8_WAIT_V(0);
    if constexpr (!ALIGN_EPI) { if (wr == 0) PG8_BAR; }
    PG8_BAR;
#undef PG8_SA
#undef PG8_SB
#undef PG8_STAGE
#undef PG8_LDA
#undef PG8_LDB
#undef PG8_MMA
#undef PG8_WAIT_V
#undef PG8_WAIT_L
#undef PG8_BAR
#undef PG8_SCHED
}
}

#define XB_TMO      128
#define XB_XCNT(j)  (256  + 64 * (j))
#define XB_XSUB(j)  (1280 + 64 * (j))
#define XB_XGEN(j)  (2304 + 64 * (j))
#define XB_TOP      3328
#define XB_TOPGEN   3392
#define XCD_BAR_WORDS 3456
#define XB_SPIN_CAP (1u << 22)
DEV unsigned xb_ld(unsigned* p)              { return __hip_atomic_load(p, __ATOMIC_RELAXED, __HIP_MEMORY_SCOPE_AGENT); }
DEV unsigned xb_add(unsigned* p, unsigned v) { return __hip_atomic_fetch_add(p, v, __ATOMIC_RELAXED, __HIP_MEMORY_SCOPE_AGENT); }
DEV unsigned xb_xcc_id() { return (unsigned)__builtin_amdgcn_s_getreg((3 << 11) | 20) & 0xFu; }
#define XB_SPIN(cond, bar) do { unsigned _sp = 0; while (cond) { __builtin_amdgcn_s_sleep(1); \
    if ((++_sp & 255u) == 0u) { if (xb_ld(&(bar)[XB_TMO])) break; if (_sp > XB_SPIN_CAP) { atomicAdd(&(bar)[XB_TMO], 1u); break; } } } } while (0)
struct XcdBarrier { unsigned* bar; unsigned x; volatile LAS unsigned* st; };
DEV XcdBarrier xcd_barrier_post(unsigned* bar, volatile LAS unsigned* st) {
    XcdBarrier b; b.bar = bar; b.x = xb_xcc_id(); b.st = st;
    if (threadIdx.x == 0) (void)xb_add(&bar[XB_XCNT(b.x)], 1u);
    return b;
}
DEV void xcd_barrier_complete(unsigned* bar, unsigned x, unsigned& nloc, unsigned& nx) {
    const unsigned G = gridDim.x * gridDim.y * gridDim.z;
    unsigned sum, cnt, mine, sp = 0u;
    for (;;) {
        sum = 0u; cnt = 0u; mine = 0u;
#pragma unroll
        for (unsigned j = 0; j < 16; ++j) { const unsigned c = xb_ld(&bar[XB_XCNT(j)]); sum += c; cnt += (c > 0u) ? 1u : 0u; mine = (j == x) ? c : mine; }
        if (sum == G) break;
        __builtin_amdgcn_s_sleep(1);
        if ((++sp & 255u) == 0u) { if (xb_ld(&bar[XB_TMO])) break; if (sp > XB_SPIN_CAP) { atomicAdd(&bar[XB_TMO], 1u); break; } }
    }
    nloc = mine > 0u ? mine : 1u; nx = cnt > 0u ? cnt : 1u;
}
DEV void xcd_barrier(const XcdBarrier& b) {
    asm volatile("s_waitcnt vmcnt(0)" ::: "memory");
    __syncthreads();
    if (threadIdx.x == 0) {
        unsigned* bar = b.bar;
        __builtin_amdgcn_s_waitcnt(0);
        unsigned nloc = b.st[0], nx = b.st[1];
        if (nloc == 0u) { xcd_barrier_complete(bar, b.x, nloc, nx); b.st[0] = nloc; b.st[1] = nx; }
        const unsigned old = xb_add(&bar[XB_XSUB(b.x)], 1u);
        const unsigned gen = old / nloc;
        if (old + 1u == (gen + 1u) * nloc) {
            __builtin_amdgcn_fence(__ATOMIC_RELEASE, "agent");
            asm volatile("s_waitcnt vmcnt(0)" ::: "memory");
            const unsigned og = xb_add(&bar[XB_TOP], 1u);
            const unsigned tg = og / nx;
            if (og + 1u == (tg + 1u) * nx) xb_add(&bar[XB_TOPGEN], 1u);
            else XB_SPIN(xb_ld(&bar[XB_TOPGEN]) == tg, bar);
            __builtin_amdgcn_fence(__ATOMIC_ACQUIRE, "agent");
            xb_add(&bar[XB_XGEN(b.x)], 1u);
            asm volatile("s_waitcnt vmcnt(0)" ::: "memory");
        } else {
            XB_SPIN(xb_ld(&bar[XB_XGEN(b.x)]) == gen, bar);
            __builtin_amdgcn_fence(__ATOMIC_ACQUIRE, "agent");
            asm volatile("s_waitcnt vmcnt(0)" ::: "memory");
        }
    }
    __syncthreads();
}

struct Args { const void* in[17]; float* out; unsigned char* ws; int ph_lo, ph_hi; };
struct Frame {
    LAS unsigned char* lds;
    int tid, lane, wave, G, bid;
    const float *x, *c, *w_ada, *b_ada, *ln1_g, *w_in, *q_norm_g, *kv_norm_g, *w_uq, *w_uk, *w_uv, *w_o, *ln2_g, *w_up, *w_dn, *final_g;
    const int* pos;
    float* out; unsigned char* ws;
};
template <class T> DEV T* wsp(const Frame& F, size_t off) { return (T*)(F.ws + off); }

DEV void p0_mod(const Frame& F) {
    LAS float* sc = (LAS float*)F.lds;
    LAS float* red = (LAS float*)(F.lds + 65536);
    for (int i = F.tid; i < NB * DM; i += 512) { const float v = F.c[i]; sc[i] = v / (1.f + __expf(-v)); }
    __syncthreads();
    float* modp = wsp<float>(F, WS_MODP);
    const int cg = F.tid & 15, rg = F.tid >> 4;
    for (int item = F.bid; item < 768; item += F.G) {
        const int cc = item >> 1, half = item & 1;
        const float* wp = F.w_ada + (size_t)(half * 2048 + rg) * (6 * DM) + cc * 64 + cg * 4;
        f32x4 a0 = {0.f, 0.f, 0.f, 0.f}, a1 = a0, a2 = a0, a3 = a0;
#pragma unroll 16
        for (int i = 0; i < 64; ++i) {
            const f32x4 w = *(const f32x4*)(wp + (size_t)i * 32 * (6 * DM));
            const int r = half * 2048 + rg + 32 * i;
            a0 += w * sc[r]; a1 += w * sc[DM + r]; a2 += w * sc[2 * DM + r]; a3 += w * sc[3 * DM + r];
        }
        *(LAS f32x4*)&red[(rg * 4 + 0) * 64 + cg * 4] = a0; *(LAS f32x4*)&red[(rg * 4 + 1) * 64 + cg * 4] = a1;
        *(LAS f32x4*)&red[(rg * 4 + 2) * 64 + cg * 4] = a2; *(LAS f32x4*)&red[(rg * 4 + 3) * 64 + cg * 4] = a3;
        __syncthreads();
        if (F.tid < 256) { const int b = F.tid >> 6, col = F.tid & 63; float s = 0.f;
#pragma unroll 8
            for (int r2 = 0; r2 < 32; ++r2) s += red[(r2 * 4 + b) * 64 + col];
            modp[(size_t)(half * 4 + b) * (6 * DM) + cc * 64 + col] = s; }
        __syncthreads();
    }
}
template <bool SCALE>
DEV void p0_transpose_item(const float* W, int K, int N, bf16* WT, const float* ks, LAS float* scr, int item, int lane, int dn0 = -1) {
    const int nblk = N / 32, kb = item / nblk, nb = item % nblk, k0 = 64 * kb, n0 = 32 * nb; if (dn0 < 0) dn0 = n0;
#pragma unroll
    for (int i = 0; i < 32; ++i) { const int kk = 2 * i + (lane >> 5); float v = W[(size_t)(k0 + kk) * N + n0 + (lane & 31)]; if (SCALE) v *= ks[k0 + kk]; scr[kk * 33 + (lane & 31)] = v; }
    LDS_WAIT(); asm volatile("" ::: "memory");
    const int c = lane & 7;
#pragma unroll
    for (int j = 0; j < 4; ++j) { const int n = (lane >> 3) + 8 * j; const LAS float* s = scr + (8 * c) * 33 + n;
        u32x4 o; o.x = pk2(s[0 * 33], s[1 * 33]); o.y = pk2(s[2 * 33], s[3 * 33]); o.z = pk2(s[4 * 33], s[5 * 33]); o.w = pk2(s[6 * 33], s[7 * 33]);
        *(u32x4*)(WT + (size_t)(dn0 + n) * K + k0 + 8 * c) = o; }
    LDS_WAIT(); asm volatile("" ::: "memory");
}
DEV void p0_transpose_item_fp8(const float* W, int K, int N, unsigned char* WT, float scale, LAS float* scr, int item, int lane, int dn0 = -1) {
    const int nblk = N / 32, kb = item / nblk, nb = item % nblk, k0 = 64 * kb, n0 = 32 * nb; if (dn0 < 0) dn0 = n0;
#pragma unroll
    for (int i = 0; i < 32; ++i) { const int kk = 2 * i + (lane >> 5); scr[kk * 33 + (lane & 31)] = W[(size_t)(k0 + kk) * N + n0 + (lane & 31)] * scale; }
    LDS_WAIT(); asm volatile("" ::: "memory");
    const int c = lane & 7;
#pragma unroll
    for (int j = 0; j < 4; ++j) { const int n = (lane >> 3) + 8 * j; const LAS float* s = scr + (8 * c) * 33 + n;
        u32x2 o; o.x = pg8::pk4_fp8(s[0 * 33], s[1 * 33], s[2 * 33], s[3 * 33]); o.y = pg8::pk4_fp8(s[4 * 33], s[5 * 33], s[6 * 33], s[7 * 33]);
        *(u32x2*)(WT + (size_t)(dn0 + n) * K + k0 + 8 * c) = o; }
    LDS_WAIT(); asm volatile("" ::: "memory");
}
DEV void p0_colmax(const Frame& F) {
    LAS float* red = (LAS float*)F.lds;
    float* cm = wsp<float>(F, WS_CMAXP);
    const int cg = F.tid & 7, rg = F.tid >> 3;
    for (int item = F.bid; item < 2 * (INW / 32); item += F.G) {
        const int cc = item >> 1, half = item & 1;
        const float* wp = F.w_in + (size_t)(half * 2048 + rg) * INW + cc * 32 + cg * 4;
        f32x4 mx = {0.f, 0.f, 0.f, 0.f};
#pragma unroll 8
        for (int i = 0; i < 32; ++i) { const f32x4 w = *(const f32x4*)(wp + (size_t)i * 64 * INW); mx = __builtin_elementwise_max(mx, __builtin_elementwise_abs(w)); }
        __syncthreads();
        *(LAS f32x4*)&red[rg * 32 + cg * 4] = mx;
        __syncthreads();
        if (F.tid < 32) { float m = 0.f;
#pragma unroll 8
            for (int r2 = 0; r2 < 64; ++r2) m = fmaxf(m, red[r2 * 32 + F.tid]);
            cm[half * 8192 + cc * 32 + F.tid] = m; }
    }
    __syncthreads();
    { float* cmu = wsp<float>(F, WS_CMAXU);
      for (int item = F.bid; item < 96 + 64 + 64; item += F.G) {
          const float* W; const float* gk; int K, N, cc, ob;
          if (item < 96) { W = F.w_uq; gk = F.q_norm_g; K = QLORA; N = NQF; cc = item; ob = 0; }
          else if (item < 160) { W = F.w_uk; gk = F.kv_norm_g; K = KVLORA; N = 2048; cc = item - 96; ob = NQF; }
          else { W = F.w_uv; gk = F.kv_norm_g; K = KVLORA; N = 2048; cc = item - 160; ob = NQF + 2048; }
          f32x4 mx = {0.f, 0.f, 0.f, 0.f};
          for (int r = rg; r < K; r += 64) { const f32x4 w = *(const f32x4*)(W + (size_t)r * N + cc * 32 + cg * 4); mx = __builtin_elementwise_max(mx, __builtin_elementwise_abs(w * gk[r])); }
          __syncthreads();
          *(LAS f32x4*)&red[rg * 32 + cg * 4] = mx;
          __syncthreads();
          if (F.tid < 32) { float m = 0.f;
#pragma unroll 8
              for (int r2 = 0; r2 < 64; ++r2) m = fmaxf(m, red[r2 * 32 + F.tid]);
              cmu[ob + cc * 32 + F.tid] = m; }
      }
      __syncthreads(); }
}
DEV void p1_win(const Frame& F) {
    LAS float* scr = (LAS float*)(F.lds + 32768 + F.wave * 8448);
    const float* cm = wsp<float>(F, WS_CMAXP); float* csb = wsp<float>(F, WS_CSB);
    unsigned char* wa = wsp<unsigned char>(F, WS_WIN); unsigned char* wb = wsp<unsigned char>(F, WS_WINB);
    const int gw = F.bid * 8 + F.wave, NGW = F.G * 8, lane = F.lane;
    constexpr int I_IN = (DM / 64) * (INW / 32);
#pragma unroll 1
    for (int item = gw; item < I_IN; item += NGW) {
        const int nblk = INW / 32, kb = item / nblk, nb = item % nblk, k0 = 64 * kb, n0 = 32 * nb;
        int dn; bool isB = false;
        if (n0 < C_KA) { isB = true; dn = B_QA + n0; } else if (n0 < C_VA) dn = A_KA + (n0 - C_KA); else if (n0 < C_QI) dn = A_VA + (n0 - C_VA); else if (n0 < C_KI) dn = A_QI + (n0 - C_QI);
        else if (n0 < C_WI) dn = A_KI + (n0 - C_KI); else if (n0 < C_CQ) dn = A_WI + (n0 - C_WI); else if (n0 < C_CKV) { isB = true; dn = B_CQ + (n0 - C_CQ); } else if (n0 < C_KR) dn = A_CKV + (n0 - C_CKV); else dn = A_KR + (n0 - C_KR);
#pragma unroll
        for (int i = 0; i < 32; ++i) { const int kk = 2 * i + (lane >> 5); scr[kk * 33 + (lane & 31)] = F.w_in[(size_t)(k0 + kk) * INW + n0 + (lane & 31)]; }
        LDS_WAIT(); asm volatile("" ::: "memory");
        if (kb == 0 && lane < 32) { const float m = fmaxf(cm[n0 + lane], cm[8192 + n0 + lane]); csb[(isB ? NA : 0) + dn + lane] = m * (1.f / 127.f); }
        const int c = lane & 7; unsigned char* WT = isB ? wb : wa;
#pragma unroll
        for (int j = 0; j < 4; ++j) { const int n = (lane >> 3) + 8 * j; const LAS float* sp = scr + (8 * c) * 33 + n;
            const float m = fmaxf(cm[n0 + n], cm[8192 + n0 + n]); const float inv = m > 0.f ? 127.f / m : 0.f;
            unsigned q[8];
#pragma unroll
            for (int e = 0; e < 8; ++e) { int v = (int)rintf(sp[e * 33] * inv); v = v > 127 ? 127 : (v < -127 ? -127 : v); q[e] = (unsigned)v & 0xffu; }
            u32x2 o; o.x = q[0] | (q[1] << 8) | (q[2] << 16) | (q[3] << 24); o.y = q[4] | (q[5] << 8) | (q[6] << 16) | (q[7] << 24);
            *(u32x2*)(WT + (size_t)(dn + n) * DM + k0 + 8 * c) = o; }
        LDS_WAIT(); asm volatile("" ::: "memory");
    }
    { const float* cmu = wsp<float>(F, WS_CMAXU); float* csu = wsp<float>(F, WS_CSU);
      constexpr int I_UQ = (QLORA / 64) * (NQF / 32), I_UK = (KVLORA / 64) * (2048 / 32);
#pragma unroll 1
      for (int it = gw; it < I_UQ + 2 * I_UK; it += NGW) {
          const float* W; const float* gk; int K, N, ob, r = it; unsigned char* WT;
          if (r < I_UQ) { W = F.w_uq; gk = F.q_norm_g; K = QLORA; N = NQF; ob = 0; WT = wsp<unsigned char>(F, WS_WUQ); }
          else if (r < I_UQ + I_UK) { r -= I_UQ; W = F.w_uk; gk = F.kv_norm_g; K = KVLORA; N = 2048; ob = NQF; WT = wsp<unsigned char>(F, WS_WUKV); }
          else { r -= I_UQ + I_UK; W = F.w_uv; gk = F.kv_norm_g; K = KVLORA; N = 2048; ob = NQF + 2048; WT = wsp<unsigned char>(F, WS_WUKV) + (size_t)2048 * KVLORA; }
          const int nblk = N / 32, kb = r / nblk, nb = r % nblk, k0 = 64 * kb, n0 = 32 * nb;
#pragma unroll
          for (int i = 0; i < 32; ++i) { const int kk = 2 * i + (lane >> 5); scr[kk * 33 + (lane & 31)] = W[(size_t)(k0 + kk) * N + n0 + (lane & 31)] * gk[k0 + kk]; }
          LDS_WAIT(); asm volatile("" ::: "memory");
          if (kb == 0 && lane < 32) csu[ob + n0 + lane] = cmu[ob + n0 + lane] * (1.f / 127.f);
          const int c = lane & 7;
#pragma unroll
          for (int j = 0; j < 4; ++j) { const int n = (lane >> 3) + 8 * j; const LAS float* sp = scr + (8 * c) * 33 + n;
              const float m = cmu[ob + n0 + n]; const float inv = m > 0.f ? 127.f / m : 0.f;
              unsigned q[8];
#pragma unroll
              for (int e = 0; e < 8; ++e) { int v = (int)rintf(sp[e * 33] * inv); v = v > 127 ? 127 : (v < -127 ? -127 : v); q[e] = (unsigned)v & 0xffu; }
              u32x2 o; o.x = q[0] | (q[1] << 8) | (q[2] << 16) | (q[3] << 24); o.y = q[4] | (q[5] << 8) | (q[6] << 16) | (q[7] << 24);
              *(u32x2*)(WT + (size_t)(n0 + n) * K + k0 + 8 * c) = o; }
          LDS_WAIT(); asm volatile("" ::: "memory");
      } }
    { u32x4* z = (u32x4*)(wa + (size_t)A_END * DM); const int n16 = (NA - A_END) * DM / 16;
      for (int i = F.bid * 512 + F.tid; i < n16; i += F.G * 512) z[i] = (u32x4){0u, 0u, 0u, 0u};
      if (F.bid == 0 && F.tid < NA - A_END) csb[A_END + F.tid] = 0.f; }
}
DEV void wt_desc(const Frame& F, int it, const float*& src, unsigned char*& dst, int& N, int& K, float& scale) {
    constexpr int I_UP = (DM / 64) * (DFF / 256), I_DN = (DFF / 64) * (DM / 256);
    const float* W; unsigned char* WT; int r = it;
    if (r < I_UP) { W = F.w_up; WT = wsp<unsigned char>(F, WS_WUP); K = DM; N = DFF; scale = 128.f; }
    else if (r < I_UP + I_DN) { r -= I_UP; W = F.w_dn; WT = wsp<unsigned char>(F, WS_WDN); K = DFF; N = DM; scale = 256.f; }
    else { r -= I_UP + I_DN; W = F.w_o; WT = wsp<unsigned char>(F, WS_WO); K = DM; N = DM; scale = 0.f; }
    const int nblk = N / 256, kb = r / nblk, nb = r % nblk;
    if (scale == 0.f) scale = (64 * kb < 2048) ? 128.f : 8.f;
    src = W + (size_t)(64 * kb) * N + 256 * nb; dst = WT + (size_t)(256 * nb) * K + 64 * kb;
}
DEV void p0_weights(const Frame& F) {
    constexpr int TS = 64 * 257;
    constexpr int NITEMS = (DM / 64) * (DFF / 256) + (DFF / 64) * (DM / 256) + (DM / 64) * (DM / 256);
    LAS float* buf = (LAS float*)F.lds;
    const int tid = F.tid, lane = F.lane, wave = F.wave;
    f32x4 r[8];
    const float* src; unsigned char* dst; int N, K; float scale;
#define WT_LOAD() do { const float* p_ = src + (size_t)(8 * wave) * N + 4 * lane; _Pragma("unroll") for (int i = 0; i < 8; ++i) r[i] = *(const f32x4*)(p_ + (size_t)i * N); } while (0)
#define WT_WRITE(sel) do { LAS float* T_ = buf + (sel) * TS + (8 * wave) * 257 + 4 * lane; _Pragma("unroll") for (int i = 0; i < 8; ++i) { T_[i * 257] = r[i].x; T_[i * 257 + 1] = r[i].y; T_[i * 257 + 2] = r[i].z; T_[i * 257 + 3] = r[i].w; } } while (0)
    int it = F.bid;
    __syncthreads();
    if (it < NITEMS) { wt_desc(F, it, src, dst, N, K, scale); WT_LOAD(); WT_WRITE(0); }
    __syncthreads();
    int sel = 0;
#pragma unroll 1
    for (; it < NITEMS; it += F.G) {
        unsigned char* cdst = dst; const int cK = K; const float cscale = scale;
        const bool more = (it + F.G < NITEMS);
        if (more) { wt_desc(F, it + F.G, src, dst, N, K, scale); WT_LOAD(); }
        { const LAS float* T = buf + sel * TS; const int c = tid & 7;
#pragma unroll
          for (int j = 0; j < 4; ++j) { const int n = (tid >> 3) + 64 * j; const LAS float* sp = T + (8 * c) * 257 + n;
              u32x2 o; o.x = pg8::pk4_fp8(sp[0 * 257] * cscale, sp[1 * 257] * cscale, sp[2 * 257] * cscale, sp[3 * 257] * cscale);
              o.y = pg8::pk4_fp8(sp[4 * 257] * cscale, sp[5 * 257] * cscale, sp[6 * 257] * cscale, sp[7 * 257] * cscale);
              *(u32x2*)(cdst + (size_t)n * cK + 8 * c) = o; } }
        if (more) WT_WRITE(sel ^ 1);
        __syncthreads();
        sel ^= 1;
    }
#undef WT_LOAD
#undef WT_WRITE
    { float* ct = wsp<float>(F, WS_COS); float* st = wsp<float>(F, WS_SIN);
      for (int i = F.bid * 512 + F.tid; i < M * 32; i += F.G * 512) { const int row = i >> 5, f = i & 31;
          const double inv = exp2(-(double)(2 * f) / 64.0 * 13.287712379549449);
          const double ang = (double)F.pos[row] * inv;
          ct[i] = (float)cos(ang); st[i] = (float)sin(ang); } }
}

DEV float modv(const Frame& F, const float* modp, int k, int b, int col) {
    return F.b_ada[k * DM + col] + modp[(size_t)(0 * 4 + b) * (6 * DM) + k * DM + col] + modp[(size_t)(1 * 4 + b) * (6 * DM) + k * DM + col];
}
template <int OUT_FP8, bool SRC_BF16>
DEV void p_adaln(const Frame& F, const void* src, const float* gain, int kshift, int kscale, bool write_gates) {
    LAS float* Al = (LAS float*)F.lds; LAS float* Bl = Al + DM;
    const float* modp = wsp<float>(F, WS_MODP); bf16* H = wsp<bf16>(F, WS_H);
    for (int rb = F.bid; rb < M / 64; rb += F.G) {
        const int b = (rb * 64) / SEQ;
        const int row0 = rb * 64 + F.wave * 8;
        f32x4 va[16], vb[16];
#define AD_LOAD(V, r) do { if (SRC_BF16) { const u32x2* xb_ = (const u32x2*)((const bf16*)src + (size_t)(r) * DM) + F.lane; _Pragma("unroll") for (int j = 0; j < 16; ++j) { const u32x2 w_ = xb_[64 * j]; V[j] = (f32x4){bflo(w_.x), bfhi(w_.x), bflo(w_.y), bfhi(w_.y)}; } } \
        else { const f32x4* xr_ = (const f32x4*)((const float*)src + (size_t)(r) * DM) + F.lane; _Pragma("unroll") for (int j = 0; j < 16; ++j) V[j] = xr_[64 * j]; } } while (0)
#define AD_PROC(V, r) do { float s_ = 0.f; _Pragma("unroll") for (int j = 0; j < 16; ++j) s_ += (V[j].x * V[j].x + V[j].y * V[j].y) + (V[j].z * V[j].z + V[j].w * V[j].w); \
            const float rstd_ = 1.f / sqrtf(wave_sum(s_) * (1.f / DM) + EPS); \
            u32x2* o8_ = (u32x2*)(H + (size_t)(r) * DM) + F.lane; unsigned* o4_ = (unsigned*)((unsigned char*)H + (size_t)(r) * DM) + F.lane; unsigned* q4_ = (unsigned*)(wsp<unsigned char>(F, WS_H8) + (size_t)(r) * DM) + F.lane; \
            const unsigned lo_ = opq(4u * (unsigned)F.lane); \
            if (OUT_FP8 == 3) {   float ym_ = 0.f; \
                _Pragma("unroll") for (int j = 0; j < 16; ++j) { const f32x4 a_ = *(const LAS f32x4*)&Al[lo_ + 256 * j], b_ = *(const LAS f32x4*)&Bl[lo_ + 256 * j]; \
                    const f32x4 y_ = V[j] * rstd_ * a_ + b_; V[j] = y_; ym_ = fmaxf(fmaxf(ym_, fmaxf(fabsf(y_.x), fabsf(y_.y))), fmaxf(fabsf(y_.z), fabsf(y_.w))); } \
                _Pragma("unroll") for (int o = 1; o < 64; o <<= 1) ym_ = fmaxf(ym_, __shfl_xor(ym_, o)); \
                const float inv_ = ym_ > 0.f ? 127.f / ym_ : 0.f; if (F.lane == 0) wsp<float>(F, WS_RSA)[r] = ym_ * (1.f / 127.f); \
                _Pragma("unroll") for (int j = 0; j < 16; ++j) { const f32x4 q_ = V[j] * inv_; \
                    o4_[64 * j] = ((unsigned)(int)rintf(q_.x) & 0xffu) | (((unsigned)(int)rintf(q_.y) & 0xffu) << 8) | (((unsigned)(int)rintf(q_.z) & 0xffu) << 16) | (((unsigned)(int)rintf(q_.w) & 0xffu) << 24); } } \
            else _Pragma("unroll") for (int j = 0; j < 16; ++j) { const f32x4 a_ = *(const LAS f32x4*)&Al[lo_ + 256 * j], b_ = *(const LAS f32x4*)&Bl[lo_ + 256 * j]; \
                const f32x4 y_ = V[j] * rstd_ * a_ + b_; \
                if (OUT_FP8 == 1) { o4_[64 * j] = pg8::pk4_fp8(fminf(fmaxf(y_.x, -448.f), 448.f), fminf(fmaxf(y_.y, -448.f), 448.f), fminf(fmaxf(y_.z, -448.f), 448.f), fminf(fmaxf(y_.w, -448.f), 448.f)); } \
                else { u32x2 w_; w_.x = pk2(y_.x, y_.y); w_.y = pk2(y_.z, y_.w); o8_[64 * j] = w_; \
                    if (OUT_FP8 == 2) q4_[64 * j] = pg8::pk4_fp8(fminf(fmaxf(y_.x, -448.f), 448.f), fminf(fmaxf(y_.y, -448.f), 448.f), fminf(fmaxf(y_.z, -448.f), 448.f), fminf(fmaxf(y_.w, -448.f), 448.f)); } } } while (0)
        AD_LOAD(va, row0);
        __syncthreads();
        for (int col = F.tid; col < DM; col += 512) { Al[col] = gain[col] * (1.f + modv(F, modp, kscale, b, col)); Bl[col] = modv(F, modp, kshift, b, col); }
        if (write_gates && (rb % (SEQ / 64)) == 0) { float* g = wsp<float>(F, WS_GATE);
            for (int col = F.tid; col < DM; col += 512) { g[b * DM + col] = modv(F, modp, 2, b, col); g[NB * DM + b * DM + col] = modv(F, modp, 5, b, col); } }
        __syncthreads();
#pragma unroll 1
        for (int i = 0; i < 8; i += 2) {
            AD_LOAD(vb, row0 + i + 1);
            AD_PROC(va, row0 + i);
            if (i + 2 < 8) AD_LOAD(va, row0 + i + 2);
            AD_PROC(vb, row0 + i + 1);
        }
#undef AD_LOAD
#undef AD_PROC
    }
}
DEV void p_final(const Frame& F) {
    const int gw = F.bid * 8 + F.wave, NGW = F.G * 8;
    f32x4 va[16], vb[16];
#define FN_LOAD(V, r) do { const u32x2* xb_ = (const u32x2*)(wsp<bf16>(F, WS_X2) + (size_t)(r) * DM) + F.lane; _Pragma("unroll") for (int j = 0; j < 16; ++j) { const u32x2 w_ = xb_[64 * j]; V[j] = (f32x4){bflo(w_.x), bfhi(w_.x), bflo(w_.y), bfhi(w_.y)}; } } while (0)
#define FN_PROC(V, r) do { float s_ = 0.f; _Pragma("unroll") for (int j = 0; j < 16; ++j) s_ += (V[j].x * V[j].x + V[j].y * V[j].y) + (V[j].z * V[j].z + V[j].w * V[j].w); \
        const float rstd_ = 1.f / sqrtf(wave_sum(s_) * (1.f / DM) + EPS); f32x4* xw_ = (f32x4*)(F.out + (size_t)(r) * DM) + F.lane; \
        _Pragma("unroll") for (int j = 0; j < 16; ++j) { const f32x4 g_ = *((const f32x4*)F.final_g + F.lane + 64 * j); xw_[64 * j] = V[j] * rstd_ * g_; } } while (0)
    int row = gw;
    if (row < M) FN_LOAD(va, row);
#pragma unroll 1
    for (; row < M; row += 2 * NGW) {
        const int r1 = row + NGW, r2 = row + 2 * NGW;
        if (r1 < M) FN_LOAD(vb, r1);
        FN_PROC(va, row);
        if (r2 < M) FN_LOAD(va, r2);
        if (r1 < M) FN_PROC(vb, r1);
    }
#undef FN_LOAD
#undef FN_PROC
}
DEV void p2_rowstats(const Frame& F) {
    const int gw = F.bid * 8 + F.wave, NGW = F.G * 8;
    const bf16* pa = wsp<bf16>(F, WS_PA); const bf16* pb = wsp<bf16>(F, WS_PB);
    float* rsq = wsp<float>(F, WS_RSQ); float* rskv = wsp<float>(F, WS_RSKV); int* ck = wsp<int>(F, WS_CK); int* tmm = wsp<int>(F, WS_TMM);
    const float* ct = wsp<float>(F, WS_COS); const float* st = wsp<float>(F, WS_SIN); bf16* kro = wsp<bf16>(F, WS_KROPE);
#pragma unroll 1
    for (int row0 = gw; row0 < M; row0 += 4 * NGW) {
        u32x4 a0[4], a1[4], c0[4]; float x1[4], x2[4], cs[4], sn[4]; int ps[4];
#pragma unroll
        for (int q = 0; q < 4; ++q) { const int row = row0 + q * NGW; const bf16* pr = pa + (size_t)row * NA; const bf16* pq = pb + (size_t)row * NBQ;
            a0[q] = *((const u32x4*)(pq + B_CQ) + F.lane); a1[q] = *((const u32x4*)(pq + B_CQ) + 64 + F.lane); c0[q] = *((const u32x4*)(pr + A_CKV) + F.lane);
            x1[q] = bf2f(pr[A_KR + (F.lane & 31)]); x2[q] = bf2f(pr[A_KR + 32 + (F.lane & 31)]); cs[q] = ct[row * 32 + (F.lane & 31)]; sn[q] = st[row * 32 + (F.lane & 31)]; ps[q] = F.pos[row]; }
#pragma unroll
        for (int q = 0; q < 4; ++q) { const int row = row0 + q * NGW; float sq = 0.f, sk = 0.f;
#pragma unroll
            for (int j = 0; j < 4; ++j) { float l0 = bflo(a0[q][j]), h0 = bfhi(a0[q][j]), l1 = bflo(a1[q][j]), h1 = bfhi(a1[q][j]), l2 = bflo(c0[q][j]), h2 = bfhi(c0[q][j]);
                sq += l0 * l0 + h0 * h0 + l1 * l1 + h1 * h1; sk += l2 * l2 + h2 * h2; }
            sq = wave_sum(sq); sk = wave_sum(sk);
            float mq = 0.f, mk = 0.f;
#pragma unroll
            for (int j = 0; j < 4; ++j) { mq = fmaxf(mq, fmaxf(fmaxf(fabsf(bflo(a0[q][j])), fabsf(bfhi(a0[q][j]))), fmaxf(fabsf(bflo(a1[q][j])), fabsf(bfhi(a1[q][j]))))); mk = fmaxf(mk, fmaxf(fabsf(bflo(c0[q][j])), fabsf(bfhi(c0[q][j])))); }
#pragma unroll
            for (int o = 1; o < 64; o <<= 1) { mq = fmaxf(mq, __shfl_xor(mq, o)); mk = fmaxf(mk, __shfl_xor(mk, o)); }
            const float iq = mq > 0.f ? 127.f / mq : 0.f, ik = mk > 0.f ? 127.f / mk : 0.f;
            if (F.lane == 0) { rsq[row] = mq * (1.f / 127.f) / sqrtf(sq * (1.f / QLORA) + EPS); rskv[row] = mk * (1.f / 127.f) / sqrtf(sk * (1.f / KVLORA) + EPS); ck[row] = floordiv64(ps[q]); }
            { auto q8 = [](unsigned w, float inv) -> unsigned { return ((unsigned)(int)rintf(bflo(w) * inv) & 0xffu) | (((unsigned)(int)rintf(bfhi(w) * inv) & 0xffu) << 8); };
              u32x2 w0, w1, w2;
              w0.x = q8(a0[q][0], iq) | (q8(a0[q][1], iq) << 16); w0.y = q8(a0[q][2], iq) | (q8(a0[q][3], iq) << 16);
              w1.x = q8(a1[q][0], iq) | (q8(a1[q][1], iq) << 16); w1.y = q8(a1[q][2], iq) | (q8(a1[q][3], iq) << 16);
              w2.x = q8(c0[q][0], ik) | (q8(c0[q][1], ik) << 16); w2.y = q8(c0[q][2], ik) | (q8(c0[q][3], ik) << 16);
              unsigned char* cq8 = wsp<unsigned char>(F, WS_CQ8) + (size_t)row * QLORA; unsigned char* ck8 = wsp<unsigned char>(F, WS_CKV8) + (size_t)row * KVLORA;
              *((u32x2*)cq8 + F.lane) = w0; *((u32x2*)(cq8 + 512) + F.lane) = w1; *((u32x2*)ck8 + F.lane) = w2; }
            if (F.lane < 32) { const float r1_ = x1[q] * cs[q] - x2[q] * sn[q], r2_ = x1[q] * sn[q] + x2[q] * cs[q]; kro[(size_t)row * 64 + F.lane] = (bf16)f2bf(r1_); kro[(size_t)row * 64 + 32 + F.lane] = (bf16)f2bf(r2_);
                unsigned char* kro8 = wsp<unsigned char>(F, WS_KROPE8); const unsigned w8_ = __builtin_amdgcn_cvt_pk_fp8_f32(r1_, r2_, 0u, false); kro8[(size_t)row * 64 + F.lane] = (unsigned char)(w8_ & 0xffu); kro8[(size_t)row * 64 + 32 + F.lane] = (unsigned char)((w8_ >> 8) & 0xffu); } }
    }
    for (int tile = gw; tile < M / 64; tile += NGW) { const int c = floordiv64(F.pos[tile * 64 + F.lane]); const int mn = wave_min_i(c), mx = wave_max_i(c);
        if (F.lane == 0) { tmm[tile] = mn; tmm[256 + tile] = mx; } }
}

typedef __bf16 bf16x2_t __attribute__((ext_vector_type(2)));
typedef short v4i16_t __attribute__((ext_vector_type(4)));
DEV unsigned cvtpk(float lo, float hi) { f32x2 v = {lo, hi}; bf16x2_t b = __builtin_convertvector(v, bf16x2_t); return __builtin_bit_cast(unsigned, b); }
DEV int crow(int r, int hi) { return (r & 3) + 8 * (r >> 2) + 4 * hi; }
#define KSWZ(row, colB) ((row) * 256 + ((colB) ^ (((row) & 15) << 4)))
DEV unsigned mbcnt64(unsigned long long m) { return __builtin_amdgcn_mbcnt_hi((unsigned)(m >> 32), __builtin_amdgcn_mbcnt_lo((unsigned)m, 0u)); }

typedef _Float16 h16x2 __attribute__((ext_vector_type(2)));
DEV float fma_mix_lo(float a, unsigned w, float c) { float d; asm("v_fma_mix_f32 %0, %1, %2, %3 op_sel:[0,0,0] op_sel_hi:[0,1,0]" : "=v"(d) : "v"(a), "v"(w), "v"(c)); return d; }
DEV float fma_mix_hi(float a, unsigned w, float c) { float d; asm("v_fma_mix_f32 %0, %1, %2, %3 op_sel:[0,1,0] op_sel_hi:[0,1,0]" : "=v"(d) : "v"(a), "v"(w), "v"(c)); return d; }
template <int VAR>
DEV void idx_phase(const Frame& F) {
    const bf16* proj = wsp<bf16>(F, WS_PA); float* sc = VAR ? wsp<float>(F, WS_MIX) : wsp<float>(F, WS_SC); const int* ck = wsp<int>(F, WS_CK); const int* tmm = wsp<int>(F, WS_TMM);
    LAS unsigned char* kl = F.lds;
    const int r32 = F.lane & 31, hi = F.lane >> 5;
    const int srow = F.tid >> 2, sch = (F.tid & 3) * 4;
    for (int p = F.bid; p < 512; p += F.G) {
#pragma unroll 1
        for (int side = 0; side < 2; ++side) {
            const int b = p >> 7, q = p & 127, g = side ? 255 - q : q;
            const int t0 = b * SEQ + 16 * g;
            const int cqmax = wave_max_i(ck[t0 + (F.lane & 15)]);
            const unsigned long long mask = __ballot(tmm[b * 64 + F.lane] <= cqmax);
            unsigned long long m2 = (mask | (mask >> 1)) & 0x5555555555555555ull;
            const int n = __popcll(m2);
            if (n == 0) continue;
            bf16x8 aq[2][8]; unsigned wq[16];
            { const bf16* qp0 = proj + (size_t)(t0 + 2 * F.wave) * NA; const bf16* qp1 = qp0 + NA;
#pragma unroll
              for (int s = 0; s < 8; ++s) { aq[0][s] = *(const bf16x8*)(qp0 + A_QI + r32 * 128 + 16 * s + 8 * hi); aq[1][s] = *(const bf16x8*)(qp1 + A_QI + r32 * 128 + 16 * s + 8 * hi); }
#pragma unroll
              for (int r = 0; r < 16; ++r) wq[r] = __builtin_bit_cast(unsigned, (h16x2){(_Float16)bf2f(qp0[A_WI + crow(r, hi)]), (_Float16)bf2f(qp1[A_WI + crow(r, hi)])}); }
            bf16x8 st[4];
#define IDX_LOAD(j2) do { const bf16* kp = proj + (size_t)(b * SEQ + 128 * (j2) + srow) * NA + A_KI + sch * 8; _Pragma("unroll") for (int c = 0; c < 4; ++c) st[c] = *(const bf16x8*)(kp + 8 * c); } while (0)
#define IDX_WRITE(buf) do { _Pragma("unroll") for (int c = 0; c < 4; ++c) *(LAS bf16x8*)(kl + (buf) * 32768 + KSWZ(srow, (sch + c) * 16)) = st[c]; } while (0)
#define IDX_LDB(BK, kb) do { _Pragma("unroll") for (int s = 0; s < 8; ++s) BK[s] = *(const LAS bf16x8*)(Ks + KSWZ(32 * (kb) + r32, (16 * s + 8 * hi) * 2)); } while (0)
#define IDX_MMA(ACC, q, BK) do { ACC = (f32x16){}; _Pragma("unroll") for (int s = 0; s < 8; ++s) ACC = __builtin_amdgcn_mfma_f32_32x32x16_bf16(aq[q][s], BK[s], ACC, 0, 0, 0); } while (0)
#define IDX_EPI(P, ACC, q) do { P = 0.f; _Pragma("unroll") for (int r = 0; r < 16; ++r) P = (q) ? fma_mix_hi(fmaxf(ACC[r], 0.f), wq[r], P) : fma_mix_lo(fmaxf(ACC[r], 0.f), wq[r], P); } while (0)
#define IDX_OUT(kb) do { auto rr = __builtin_amdgcn_permlane32_swap(__float_as_uint(p0), __float_as_uint(p1), false, false); \
        sc[(size_t)(t0 + 2 * F.wave + hi) * SEQ + 128 * j + 32 * (kb) + r32] = __uint_as_float(rr[0]) + __uint_as_float(rr[1]); } while (0)
            int j = __builtin_ctzll(m2) >> 1; m2 &= m2 - 1;
            __syncthreads();
            IDX_LOAD(j); IDX_WRITE(0); __syncthreads();
#pragma unroll 1
            for (int i = 0; i < n; ++i) {
                const bool more = (i + 1 < n);
                int jn = j; if (more) { jn = __builtin_ctzll(m2) >> 1; m2 &= m2 - 1; IDX_LOAD(jn); }
                const LAS unsigned char* Ks = kl + (i & 1) * 32768;
                bf16x8 bkA[8], bkB[8]; f32x16 acc0, acc1; float p0, p1;
                IDX_LDB(bkA, 0); SBAR(); IDX_LDB(bkB, 1); SBAR();
                IDX_MMA(acc0, 0, bkA); SBAR();
                IDX_MMA(acc1, 1, bkA); IDX_EPI(p0, acc0, 0); SBAR();
                IDX_LDB(bkA, 2); SBAR();
                IDX_MMA(acc0, 0, bkB); IDX_EPI(p1, acc1, 1); IDX_OUT(0); SBAR();
                IDX_MMA(acc1, 1, bkB); IDX_EPI(p0, acc0, 0); SBAR();
                IDX_LDB(bkB, 3); SBAR();
                IDX_MMA(acc0, 0, bkA); IDX_EPI(p1, acc1, 1); IDX_OUT(1); SBAR();
                IDX_MMA(acc1, 1, bkA); IDX_EPI(p0, acc0, 0); SBAR();
                IDX_MMA(acc0, 0, bkB); IDX_EPI(p1, acc1, 1); IDX_OUT(2); SBAR();
                IDX_MMA(acc1, 1, bkB); IDX_EPI(p0, acc0, 0); SBAR();
                IDX_EPI(p1, acc1, 1); IDX_OUT(3);
                if (more) IDX_WRITE((i + 1) & 1);
                __syncthreads();
                j = jn;
            }
#undef IDX_LOAD
#undef IDX_WRITE
#undef IDX_LDB
#undef IDX_MMA
#undef IDX_EPI
#undef IDX_OUT
        }
    }
}

DEV unsigned f2ord(float f) { const unsigned u = __float_as_uint(f); return (u & 0x80000000u) ? ~u : (u | 0x80000000u); }
#if defined(DBG) && DBG
#define TOPK_GLOBAL 1
#else
#define TOPK_GLOBAL 0
#endif
template <int NS, bool TOLDS = false>
DEV int topk_row(const Frame& F, int t, int b, int cq, unsigned long long vis, unsigned long long part, LAS int* idxl = nullptr) {
    const float* sc = wsp<float>(F, WS_SC); const int* ck = wsp<int>(F, WS_CK); int* idx = wsp<int>(F, WS_IDX); int* cnt = wsp<int>(F, WS_CNT);
    unsigned u[NS]; int nadm = 0;
    constexpr bool KEEPG = !TOLDS || TOPK_GLOBAL;
    const float* srow = sc + (size_t)t * SEQ; const unsigned l4 = opq(4u * (unsigned)F.lane);
#pragma unroll
    for (int j = 0; j < NS; ++j) { float s = 0.f; if ((vis >> j) & 1ull) s = ldg<float>(srow + 64 * j, l4); u[j] = __float_as_uint(s); }
#pragma unroll
    for (int j = 0; j < NS; ++j) { unsigned v = 0u; if ((vis >> j) & 1ull) { v = f2ord(__uint_as_float(u[j])); v = v ? v : 1u; } u[j] = v; }
    if (part) {
#pragma unroll
        for (int j = 0; j < NS; ++j) if ((part >> j) & 1ull) { if (ck[b * SEQ + 64 * j + F.lane] > cq) u[j] = 0u; }
    }
#pragma unroll
    for (int j = 0; j < NS; ++j) nadm += __popcll(__ballot(u[j] != 0u));
    unsigned T = 0u; int need_eq = 0;
    if (nadm > TOPK) {
        unsigned umax = 0u;
#pragma unroll
        for (int j = 0; j < NS; ++j) umax = u[j] > umax ? u[j] : umax;
#pragma unroll
        for (int o = 1; o < 64; o <<= 1) { const unsigned v = (unsigned)__shfl_xor((int)umax, o); umax = v > umax ? v : umax; }
        umax = __builtin_amdgcn_readfirstlane(umax);
#pragma unroll 1
        for (int bit = 31; bit >= 0; --bit) { const unsigned cand = T | (1u << bit); if (cand > umax) continue; int c = 0;
#pragma unroll
            for (int j = 0; j < NS; ++j) c += __popcll(__ballot(u[j] >= cand));
            if (c >= TOPK) { T = cand; if (c == TOPK) break; } }
        int cgt = 0;
#pragma unroll
        for (int j = 0; j < NS; ++j) cgt += __popcll(__ballot(u[j] > T));
        need_eq = TOPK - cgt;
    }
    int base = 0, eqbase = 0; int* orow = idx + (size_t)t * TOPK; const int lnk = (int)opq((unsigned)F.lane);
#pragma unroll
    for (int j = 0; j < NS; ++j) { const bool gt = u[j] > T, eq = (u[j] == T);
        const unsigned long long meq = __ballot(eq); const bool take = gt || (eq && (int)(eqbase + mbcnt64(meq)) < need_eq);
        const unsigned long long mt = __ballot(take); if (take) { const int p_ = base + (int)mbcnt64(mt); if (KEEPG) orow[p_] = 64 * j + lnk; if (TOLDS) idxl[p_] = 64 * j + lnk; }
        base += __popcll(mt); eqbase += __popcll(meq); }
    if (KEEPG && F.lane == 0) cnt[t] = base;
    return base;
}
DEV void topk_phase(const Frame& F) {
    const int* ck = wsp<int>(F, WS_CK); const int* tmm = wsp<int>(F, WS_TMM);
    const int gw = F.bid * 8 + F.wave, NGW = F.G * 8;
#pragma unroll 1
    for (int t = gw; t < M; t += NGW) {
        const int b = t / SEQ; const int cq = __builtin_amdgcn_readfirstlane(ck[t]);
        const int tmn = tmm[b * 64 + F.lane], tmx = tmm[256 + b * 64 + F.lane];
        const unsigned long long vis = __ballot(tmn <= cq), part = __ballot(tmn <= cq && tmx > cq);
        if ((vis >> 16) == 0ull) topk_row<16>(F, t, b, cq, vis, part);
        else if ((vis >> 32) == 0ull) topk_row<32>(F, t, b, cq, vis, part);
        else if ((vis >> 48) == 0ull) topk_row<48>(F, t, b, cq, vis, part);
        else topk_row<64>(F, t, b, cq, vis, part);
    }
}

DEV long sp_bf8_fp8(bf16x8 v) { const u32x4 w = __builtin_bit_cast(u32x4, v);
    u32x2 r; r.x = pg8::pk4_fp8(__uint_as_float(w.x << 16), __uint_as_float(w.x & 0xffff0000u), __uint_as_float(w.y << 16), __uint_as_float(w.y & 0xffff0000u));
    r.y = pg8::pk4_fp8(__uint_as_float(w.z << 16), __uint_as_float(w.z & 0xffff0000u), __uint_as_float(w.w << 16), __uint_as_float(w.w & 0xffff0000u)); return __builtin_bit_cast(long, r); }
DEV bf16x8 sp_fp8_bf8(u32x2 w) {
    const f32x2 a = __builtin_amdgcn_cvt_pk_f32_fp8((int)w.x, false), b = __builtin_amdgcn_cvt_pk_f32_fp8((int)w.x, true), c = __builtin_amdgcn_cvt_pk_f32_fp8((int)w.y, false), d = __builtin_amdgcn_cvt_pk_f32_fp8((int)w.y, true);
    const u32x4 o = {cvtpk(a.x, a.y), cvtpk(b.x, b.y), cvtpk(c.x, c.y), cvtpk(d.x, d.y)}; return __builtin_bit_cast(bf16x8, o); }
DEV unsigned offb(unsigned row, unsigned ch) { return 256u * row + 16u * (ch ^ (((row & 3u) << 2) | ((row >> 2) & 3u))); }
DEV s16x4 vtr(const LAS unsigned char* p) { return __builtin_bit_cast(s16x4, __builtin_amdgcn_ds_read_tr16_b64_v4i16((LAS v4i16_t*)p)); }
template <bool FUSED>
DEV void sparse_phase(const Frame& F) {
    const bf16* proj = wsp<bf16>(F, WS_PA); const bf16* projb = wsp<bf16>(F, WS_PB); const int* idxg = wsp<int>(F, WS_IDX); const int* cntg = wsp<int>(F, WS_CNT); unsigned char* mix = wsp<unsigned char>(F, WS_MIX);
    LAS unsigned char* wl = F.lds + F.wave * 10240;
    LAS int* idxl = (LAS int*)wl; LAS float* distl = (LAS float*)(wl + 1024); LAS unsigned char* vimg = wl + 2048;
    const float LOG2E = 1.4426950408889634f;
    const float qscale = 0.088388347648318440f * LOG2E;
    const bool xmap = (F.G == 256);
    const int xcd = F.bid & 7, wi = ((F.bid >> 3) << 1) | (xcd & 1);
    const int tbase = xmap ? (xcd >> 1) * SEQ + wi * 64 + F.wave * 8 : F.bid * 8 + F.wave, tstep = xmap ? 1 : F.G * 8, tcount = xmap ? 8 : (M - tbase + F.G * 8 - 1) / (F.G * 8);
    i32x4 nid = {0, 0, 0, 0}, nps = {0, 0, 0, 0}; int nn = 0, npt = 0;
    if (!FUSED && tcount > 0) { const int t0 = tbase; nid = *(const i32x4*)(idxg + (size_t)t0 * TOPK + 4 * F.lane); nn = cntg[t0]; npt = F.pos[t0];
#pragma unroll
        for (int c = 0; c < 4; ++c) { const bool ok = (4 * F.lane + c) < nn; const int ii = ok ? nid[c] : 0; nid[c] = ii; nps[c] = F.pos[(t0 / SEQ) * SEQ + ii]; } }
#pragma unroll 1
    for (int qi = 0; qi < tcount; ++qi) {
        const int t = (FUSED && xmap) ? (xcd >> 1) * SEQ + ((((qi >> 2) ^ (F.wave >> 2)) & 1) ? 127 - wi : wi) * 32 + F.wave * 4 + (qi & 3) : tbase + qi * tstep;
        const int b = t / SEQ; int n = nn; int pt = npt;
        if (FUSED) {
            const int* ck = wsp<int>(F, WS_CK); const int* tmm = wsp<int>(F, WS_TMM);
            const int cq = __builtin_amdgcn_readfirstlane(ck[t]); pt = F.pos[t];
            const int tmn = tmm[b * 64 + F.lane], tmx = tmm[256 + b * 64 + F.lane];
            const unsigned long long vis = __ballot(tmn <= cq), part = __ballot(tmn <= cq && tmx > cq);
            if ((vis >> 16) == 0ull) n = topk_row<16, true>(F, t, b, cq, vis, part, idxl);
            else if ((vis >> 32) == 0ull) n = topk_row<32, true>(F, t, b, cq, vis, part, idxl);
            else if ((vis >> 48) == 0ull) n = topk_row<48, true>(F, t, b, cq, vis, part, idxl);
            else n = topk_row<64, true>(F, t, b, cq, vis, part, idxl);
            i32x4 idv = *(const LAS i32x4*)(idxl + 4 * F.lane); f32x4 ds;
#pragma unroll
            for (int c = 0; c < 4; ++c) { const bool ok = (4 * F.lane + c) < n; const int ii = ok ? idv[c] : 0; idv[c] = ii; const int ps = F.pos[b * SEQ + ii]; ds[c] = ok ? fabsf((float)(pt - ps)) : __builtin_inff(); }
            *(LAS i32x4*)(idxl + 4 * F.lane) = idv; *(LAS f32x4*)(distl + 4 * F.lane) = ds;
        } else { f32x4 ds;
#pragma unroll
          for (int c = 0; c < 4; ++c) ds[c] = ((4 * F.lane + c) < n) ? fabsf((float)(pt - nps[c])) : __builtin_inff();
          *(LAS i32x4*)(idxl + 4 * F.lane) = nid; *(LAS f32x4*)(distl + 4 * F.lane) = ds; }
        const int lz_ = (int)opq((unsigned)F.lane); const int l15 = lz_ & 15, g = lz_ >> 4, q4 = l15 >> 2, p4 = l15 & 3;
        const float slope2 = exp2f(-0.5f * (float)(l15 + 1)) * LOG2E;
        const int tn = t + tstep; const bool has_next = !FUSED && (qi + 1 < tcount);
        if (has_next) { nid = *(const i32x4*)(idxg + (size_t)tn * TOPK + 4 * F.lane); nn = cntg[tn]; npt = F.pos[tn]; }
        const unsigned char* pk_ = wsp<unsigned char>(F, WS_KAV8) + (size_t)(b * SEQ) * 256;
        long qf[2][2];
#pragma unroll
        for (int kk = 0; kk < 2; ++kk)
#pragma unroll
            for (int t2 = 0; t2 < 2; ++t2) qf[kk][t2] = sp_bf8_fp8(*(const bf16x8*)(projb + (size_t)t * NBQ + B_QA + l15 * 128 + 64 * kk + 16 * g + 8 * t2));
        f32x4 s[16];
        u32x4 kf[4][4][2];
#define SP_LOADK(buf, j4) do { _Pragma("unroll") for (int jj = 0; jj < 4; ++jj) { const unsigned ko_ = (unsigned)(idxl[16 * ((j4) * 4 + jj) + l15] * 256 + 16 * g); \
            _Pragma("unroll") for (int kk = 0; kk < 2; ++kk) kf[buf][jj][kk] = ldg<u32x4>(pk_, ko_, kk * 64); } } while (0)
        SP_LOADK(0, 0); SP_LOADK(1, 1); SP_LOADK(2, 2); SP_LOADK(3, 3);
#pragma unroll
        for (int j4 = 0; j4 < 4; ++j4) {
#pragma unroll
            for (int jj = 0; jj < 4; ++jj) { f32x4 a = {0.f, 0.f, 0.f, 0.f};
#pragma unroll
                for (int kk = 0; kk < 2; ++kk) { const u32x4 kv_ = kf[j4][jj][kk];
                    a = __builtin_amdgcn_mfma_f32_16x16x32_fp8_fp8(__builtin_bit_cast(long, (u32x2){kv_.x, kv_.y}), qf[kk][0], a, 0, 0, 0);
                    a = __builtin_amdgcn_mfma_f32_16x16x32_fp8_fp8(__builtin_bit_cast(long, (u32x2){kv_.z, kv_.w}), qf[kk][1], a, 0, 0, 0); }
                s[j4 * 4 + jj] = a; }
        }
#undef SP_LOADK
        u32x2 vst[4][8];
#define SP_LOADV(buf, u) do { _Pragma("unroll") for (int i = 0; i < 8; ++i) { const unsigned vo_ = (unsigned)(idxl[32 * (u) + 4 * i + g] * 256 + 128 + 8 * l15); vst[buf][i] = ldg<u32x2>(pk_, vo_); } } while (0)
        SP_LOADV(0, 0); SP_LOADV(1, 1); SP_LOADV(2, 2); SP_LOADV(3, 3);
        if (has_next) {
#pragma unroll
            for (int c = 0; c < 4; ++c) { const bool ok = (4 * F.lane + c) < nn; const int ii = ok ? nid[c] : 0; nid[c] = ii; nps[c] = F.pos[(tn / SEQ) * SEQ + ii]; } }
        float mx = -__builtin_inff();
#pragma unroll
        for (int jb = 0; jb < 16; ++jb) { const f32x4 dv = *(const LAS f32x4*)(distl + 16 * jb + 4 * g);
#pragma unroll
            for (int i = 0; i < 4; ++i) { const float v = s[jb][i] * qscale - slope2 * dv[i]; s[jb][i] = v; mx = fmaxf(mx, v); } }
        mx = fmaxf(mx, __shfl_xor(mx, 16)); mx = fmaxf(mx, __shfl_xor(mx, 32));
        float sum = 0.f;
#pragma unroll
        for (int jb = 0; jb < 16; ++jb)
#pragma unroll
            for (int i = 0; i < 4; ++i) { const float p = __builtin_amdgcn_exp2f(s[jb][i] - mx); s[jb][i] = p; sum += p; }
        sum += __shfl_xor(sum, 16); sum += __shfl_xor(sum, 32);
        bf16x8 pf[8];
#pragma unroll
        for (int u = 0; u < 8; ++u) { u32x4 w = {cvtpk(s[2 * u][0], s[2 * u][1]), cvtpk(s[2 * u][2], s[2 * u][3]), cvtpk(s[2 * u + 1][0], s[2 * u + 1][1]), cvtpk(s[2 * u + 1][2], s[2 * u + 1][3])};
            pf[u] = __builtin_bit_cast(bf16x8, w); }
        f32x4 o[8];
#pragma unroll
        for (int mb = 0; mb < 8; ++mb) o[mb] = (f32x4){0.f, 0.f, 0.f, 0.f};
#pragma unroll
        for (int u = 0; u < 8; ++u) {
#pragma unroll
            for (int i = 0; i < 8; ++i) *(LAS bf16x8*)(vimg + offb(4 * i + g, l15)) = sp_fp8_bf8(vst[u & 3][i]);
            if (u + 4 < 8) SP_LOADV(u & 3, u + 4);
#pragma unroll
            for (int mb = 0; mb < 8; ++mb) {
                const s16x4 lo = vtr(vimg + offb(4 * g + q4, 2 * mb + (p4 >> 1)) + 8 * (p4 & 1));
                const s16x4 hh = vtr(vimg + offb(16 + 4 * g + q4, 2 * mb + (p4 >> 1)) + 8 * (p4 & 1));
                const bf16x8 af = {lo[0], lo[1], lo[2], lo[3], hh[0], hh[1], hh[2], hh[3]};
                o[mb] = __builtin_amdgcn_mfma_f32_16x16x32_bf16(af, pf[u], o[mb], 0, 0, 0);
            }
        }
#undef SP_LOADV
        const float inv = 1.f / sum;
#pragma unroll
        for (int mb = 0; mb < 8; ++mb)
            *(unsigned*)(mix + (size_t)t * DM + l15 * 128 + 16 * mb + 4 * g) = pg8::pk4_fp8(o[mb][0] * inv, o[mb][1] * inv, o[mb][2] * inv, o[mb][3] * inv);
    }
}

namespace mla {
constexpr int KROW = 208, KBUF = 64 * KROW, VROW = 80, VBUF = 128 * VROW;
constexpr int L_K = 0, L_V = 2 * KBUF, L_CKT = L_V + 2 * VBUF, L_WS = L_CKT + 512, L_TL = L_WS + 8 * 256, L_TMX = L_TL + 512, L_END = L_TMX + 512;
static_assert(L_END <= RING_BYTES, "mla LDS map");
constexpr float SCALE = 0.07216878364870323f;
constexpr float THR = 6.f;
constexpr float MASKV = -30000.f;
constexpr int IMAX = 0x7fffffff;
DEV void partialSM(f32x16& p0, f32x16& p1, float& m_reg, float& mn, float& alpha) {
    constexpr float C = SCALE * 1.4426950408889634f;
    float pmax = p0[0];
#pragma unroll
    for (int r = 1; r < 16; ++r) pmax = fmaxf(pmax, p0[r]);
#pragma unroll
    for (int r = 0; r < 16; ++r) pmax = fmaxf(pmax, p1[r]);
    { auto rr = __builtin_amdgcn_permlane32_swap(__float_as_uint(pmax), __float_as_uint(pmax), false, false); pmax = fmaxf(__uint_as_float(rr[0]), __uint_as_float(rr[1])); }
    if (__builtin_expect(__all(pmax - m_reg <= THR / SCALE), 1)) { mn = m_reg; alpha = 1.f; }
    else { mn = fmaxf(m_reg, pmax); alpha = __builtin_amdgcn_exp2f((m_reg - mn) * C); m_reg = mn; }
    const float mnC = -mn * C;
    const f32x2 C2 = {C, C}, mn2 = {mnC, mnC};
#pragma unroll
    for (int r = 0; r < 16; r += 2) { const f32x2 t = __builtin_elementwise_fma((f32x2){p0[r], p0[r + 1]}, C2, mn2); p0[r] = t.x; p0[r + 1] = t.y; }
#pragma unroll
    for (int r = 0; r < 16; r += 2) { const f32x2 t = __builtin_elementwise_fma((f32x2){p1[r], p1[r + 1]}, C2, mn2); p1[r] = t.x; p1[r + 1] = t.y; }
#pragma unroll
    for (int r = 0; r < 16; ++r) p0[r] = __builtin_amdgcn_exp2f(p0[r]);
}
DEV void finishSM(f32x16& p0, f32x16& p1, float alpha, float& l_reg, pg8::v8i& P8) {
#pragma unroll
    for (int r = 0; r < 16; ++r) p1[r] = __builtin_amdgcn_exp2f(p1[r]);
    f32x2 s2 = (f32x2){p0[0], p0[1]} + (f32x2){p1[0], p1[1]};
#pragma unroll
    for (int r = 2; r < 16; r += 2) s2 += (f32x2){p0[r], p0[r + 1]} + (f32x2){p1[r], p1[r + 1]};
    float ps = s2.x + s2.y;
    { auto rr = __builtin_amdgcn_permlane32_swap(__float_as_uint(ps), __float_as_uint(ps), false, false); ps = __uint_as_float(rr[0]) + __uint_as_float(rr[1]); }
    l_reg = l_reg * alpha + ps;
#pragma unroll
    for (int w = 0; w < 4; ++w) { P8[w] = (int)pg8::pk4_fp8(p0[4 * w], p0[4 * w + 1], p0[4 * w + 2], p0[4 * w + 3]); P8[4 + w] = (int)pg8::pk4_fp8(p1[4 * w], p1[4 * w + 1], p1[4 * w + 2], p1[4 * w + 3]); }
}
DEV u32x2 bf8_fp8(bf16x8 v) { const u32x4 w = __builtin_bit_cast(u32x4, v); u32x2 r;
    r.x = __builtin_amdgcn_cvt_pk_fp8_f32(__uint_as_float(w.x << 16), __uint_as_float(w.x & 0xffff0000u), 0u, false);
    r.x = __builtin_amdgcn_cvt_pk_fp8_f32(__uint_as_float(w.y << 16), __uint_as_float(w.y & 0xffff0000u), r.x, true);
    r.y = __builtin_amdgcn_cvt_pk_fp8_f32(__uint_as_float(w.z << 16), __uint_as_float(w.z & 0xffff0000u), 0u, false);
    r.y = __builtin_amdgcn_cvt_pk_fp8_f32(__uint_as_float(w.w << 16), __uint_as_float(w.w & 0xffff0000u), r.y, true);
    return r; }
DEV void qkt(f32x16& p0, f32x16& p1, const LAS unsigned char* Ks, const pg8::v8i (&q8)[3], int r32, int hi) {
    p0 = (f32x16){}; p1 = (f32x16){};
#pragma unroll
    for (int c = 0; c < 3; ++c) { const int cb = c * 64 + hi * 32;
        const pg8::v8i b0 = *(const LAS pg8::v8i*)(Ks + r32 * KROW + cb);
        const pg8::v8i b1 = *(const LAS pg8::v8i*)(Ks + (32 + r32) * KROW + cb);
        p0 = __builtin_amdgcn_mfma_scale_f32_32x32x64_f8f6f4(b0, q8[c], p0, 0, 0, 0, 0x7f7f7f7f, 0, 0x7f7f7f7f);
        p1 = __builtin_amdgcn_mfma_scale_f32_32x32x64_f8f6f4(b1, q8[c], p1, 0, 0, 0, 0x7f7f7f7f, 0, 0x7f7f7f7f);
        if (c == 0) asm volatile("" :: "v"(b0), "v"(b1));
    }
}
DEV void maskt(f32x16& p0, f32x16& p1, const LAS int* ck64, int cq, int hi) {
#pragma unroll
    for (int r = 0; r < 16; ++r) { if (ck64[crow(r, hi)] > cq) p0[r] = MASKV; if (ck64[32 + crow(r, hi)] > cq) p1[r] = MASKV; }
}
DEV void pv_d0(f32x16 (&o)[4], const LAS unsigned char* vb, const pg8::v8i& P8) {
#pragma unroll
    for (int d = 0; d < 4; d += 2) { const pg8::v8i bv0 = *(const LAS pg8::v8i*)(vb + d * 32 * VROW), bv1 = *(const LAS pg8::v8i*)(vb + (d + 1) * 32 * VROW);
        o[d] = __builtin_amdgcn_mfma_scale_f32_32x32x64_f8f6f4(P8, bv0, o[d], 0, 0, 0, 0x7f7f7f7f, 0, 0x7f7f7f7f);
        o[d + 1] = __builtin_amdgcn_mfma_scale_f32_32x32x64_f8f6f4(P8, bv1, o[d + 1], 0, 0, 0, 0x7f7f7f7f, 0, 0x7f7f7f7f); }
}
}

DEV void mla_phase(const Frame& F) {
    using namespace mla;
    const bf16* qfp = wsp<bf16>(F, WS_QF); const unsigned char* kv = wsp<unsigned char>(F, WS_KV); const unsigned char* kro = wsp<unsigned char>(F, WS_KROPE8);
    const int* ck = wsp<int>(F, WS_CK); const int* tmm = wsp<int>(F, WS_TMM); const float* ct = wsp<float>(F, WS_COS); const float* st = wsp<float>(F, WS_SIN);
    unsigned char* mix = wsp<unsigned char>(F, WS_MIX);
    const int tid = F.tid, wid = F.wave, lane = F.lane, r32 = lane & 31, hi = lane >> 5;
    LAS unsigned char* Kl = F.lds + L_K; LAS unsigned char* Vl = F.lds + L_V; LAS int* ckt = (LAS int*)(F.lds + L_CKT);
    LAS float* li_l = (LAS float*)(F.lds + L_WS) + wid * 64; LAS float* al_l = li_l + 32;
    LAS int* tl = (LAS int*)(F.lds + L_TL); LAS int* tlmx = (LAS int*)(F.lds + L_TMX);
    const int vcu = (F.G % 8 == 0) ? (F.bid % 8) * (F.G / 8) + F.bid / 8 : F.bid;
    const int krow = tid >> 3, kc8 = tid & 7;
    const unsigned koff = (unsigned)(krow * NKV + kc8 * 8);
#pragma unroll 1
    for (int pp = vcu; pp < 512; pp += F.G) {
#pragma unroll 1
        for (int side = 0; side < 2; ++side) {
            const int bh = pp >> 3, pr = pp & 7, b = bh >> 4, h = bh & 15, qb = side ? 15 - pr : pr;
            const int trow0 = b * SEQ + qb * 256, trow = trow0 + wid * 32 + r32;
            const unsigned lz = opq((unsigned)lane), r32z = lz & 31u, hiz = lz >> 5;
            LAS unsigned char* vwr = Vl + (4 * r32z) * VROW + (wid & 1) * 32 + (wid >> 1) * 4 + 16 * hiz;
            const LAS unsigned char* vb0 = Vl + r32z * VROW + hiz * 32;
            const int cq = ldg<int>(ck + trow0 + wid * 32, r32z * 4u);
            const i32x4 c4 = ldg<i32x4>(ck + trow0, lz * 16u);
            int cmx = c4.x > c4.y ? c4.x : c4.y; cmx = cmx > c4.z ? cmx : c4.z; cmx = cmx > c4.w ? cmx : c4.w;
            const int cqmax = wave_max_i(cmx), wmin = wave_min_i(cq);
            const int tmn_l = ldg<int>(tmm + b * 64, lz * 4u), tmx_l = ldg<int>(tmm + 256 + b * 64, lz * 4u);
            const unsigned long long mask = __ballot(tmn_l <= cqmax);
            const int NT = __popcll(mask), NT2 = NT + (NT & 1);
            __syncthreads();
            if ((mask >> lz) & 1ull) { const int rank = (int)mbcnt64(mask); tl[rank] = (int)lz; tlmx[rank] = tmx_l; }
            if ((NT & 1) && lane == 0) { tl[NT] = 63 - __builtin_clzll(mask); tlmx[NT] = IMAX; }
            __syncthreads();
            bf16x8 qb16[12];
            { const unsigned qo = (r32z * NQF + hiz * 8) * 2u; const bf16* Qb = qfp + (size_t)(trow0 + wid * 32) * NQF + h * 192;
#pragma unroll
              for (int d0 = 0; d0 < 12; ++d0) qb16[d0] = ldg<bf16x8>(Qb, qo, d0 * 32);
              const unsigned co = (r32z * 32 + hiz * 8) * 4u; const float* cb_ = ct + (size_t)(trow0 + wid * 32) * 32; const float* sb_ = st + (size_t)(trow0 + wid * 32) * 32;
#pragma unroll
              for (int dd = 0; dd < 2; ++dd) {
                  const f32x4 c0 = ldg<f32x4>(cb_, co, dd * 64), c1 = ldg<f32x4>(cb_, co, dd * 64 + 16), s0 = ldg<f32x4>(sb_, co, dd * 64), s1 = ldg<f32x4>(sb_, co, dd * 64 + 16);
#pragma unroll
                  for (int e = 0; e < 8; ++e) { const float x1 = bf2f((unsigned short)qb16[8 + dd][e]), x2 = bf2f((unsigned short)qb16[10 + dd][e]);
                      const float c = e < 4 ? c0[e & 3] : c1[e & 3], s = e < 4 ? s0[e & 3] : s1[e & 3];
                      qb16[8 + dd][e] = (short)f2bf(x1 * c - x2 * s); qb16[10 + dd][e] = (short)f2bf(x1 * s + x2 * c); } } }
            pg8::v8i qr[3];
#pragma unroll
            for (int c = 0; c < 3; ++c) { const u32x2 a0 = bf8_fp8(qb16[4 * c]), a1 = bf8_fp8(qb16[4 * c + 1]), a2 = bf8_fp8(qb16[4 * c + 2]), a3 = bf8_fp8(qb16[4 * c + 3]);
                qr[c] = (pg8::v8i){(int)a0.x, (int)a0.y, (int)a1.x, (int)a1.y, (int)a2.x, (int)a2.y, (int)a3.x, (int)a3.y}; }
            float m_reg = -1e30f, l_reg = 0.f; f32x16 o[4] = {};
            u32x2 sk0, sk1, sk2; unsigned sv[4]; int sck = 0;
#define SLOAD(i) do { const int tj_ = __builtin_amdgcn_readfirstlane(tl[i]), kmx_ = __builtin_amdgcn_readfirstlane(tlmx[i]); const unsigned keyb_ = (unsigned)(b * SEQ + tj_ * 64); \
        const unsigned char* kb_ = kv + (size_t)keyb_ * NKV + h * 128; const unsigned ko_ = opq(koff), lo_ = opq((unsigned)lane), vo_ = (lo_ >> 5) * (32u * NKV) + (lo_ & 31u) * 4u, to_ = opq((unsigned)tid); \
        sk0 = ldg<u32x2>(kb_, ko_); sk1 = ldg<u32x2>(kb_, ko_, 64); sk2 = ldg<u32x2>(kro + (size_t)keyb_ * 64, to_ * 8u); \
        { const unsigned char* vb_ = kb_ + 2048 + (size_t)(4 * wid) * NKV; _Pragma("unroll") for (int b_ = 0; b_ < 4; ++b_) sv[b_] = ldg<unsigned>(vb_ + (size_t)b_ * NKV, vo_); } \
        if (tid < 64) sck = (kmx_ == IMAX) ? IMAX : ldg<int>(ck + keyb_, to_ * 4u); } while (0)
#define SWRITE(buf) do { LAS unsigned char* kb_ = Kl + (buf) * KBUF + krow * KROW + (kc8 & 1) * 32 + (kc8 >> 1) * 8; *(LAS u32x2*)kb_ = sk0; *(LAS u32x2*)(kb_ + 64) = sk1; *(LAS u32x2*)(kb_ + 128) = sk2; \
        { const unsigned t0_ = __builtin_amdgcn_perm(sv[1], sv[0], 0x05010400u), t1_ = __builtin_amdgcn_perm(sv[1], sv[0], 0x07030602u), u0_ = __builtin_amdgcn_perm(sv[3], sv[2], 0x05010400u), u1_ = __builtin_amdgcn_perm(sv[3], sv[2], 0x07030602u); \
          *(LAS unsigned*)(vwr + (buf) * VBUF) = __builtin_amdgcn_perm(u0_, t0_, 0x05040100u); *(LAS unsigned*)(vwr + (buf) * VBUF + VROW) = __builtin_amdgcn_perm(u0_, t0_, 0x07060302u); \
          *(LAS unsigned*)(vwr + (buf) * VBUF + 2 * VROW) = __builtin_amdgcn_perm(u1_, t1_, 0x05040100u); *(LAS unsigned*)(vwr + (buf) * VBUF + 3 * VROW) = __builtin_amdgcn_perm(u1_, t1_, 0x07060302u); } \
        if (tid < 64) ckt[(buf) * 64 + tid] = sck; } while (0)
#define RESC(a) do { if (__any((a) < 1.f)) { if (hi == 0) al_l[r32] = (a); asm volatile("s_waitcnt lgkmcnt(0)" ::: "memory"); \
        _Pragma("unroll") for (int d = 0; d < 4; ++d) _Pragma("unroll") for (int r = 0; r < 16; ++r) o[d][r] *= al_l[crow(r, hi)]; } } while (0)
#define MASKIF(P0, P1, i, buf) do { if (__builtin_amdgcn_readfirstlane(tlmx[i]) > wmin) maskt(P0, P1, ckt + (buf) * 64, cq, hi); } while (0)
            f32x16 pA0, pA1, pB0, pB1; float mnA, mnB, alA, alB; pg8::v8i P8;
            SLOAD(0); SWRITE(0); __syncthreads();
            qkt(pA0, pA1, Kl, qr, r32, hi); MASKIF(pA0, pA1, 0, 0); partialSM(pA0, pA1, m_reg, mnA, alA);
            SLOAD(1); SWRITE(1); __syncthreads();
#pragma unroll 1
            for (int j = 1; j + 1 < NT2; j += 2) {
                SBAR(); qkt(pB0, pB1, Kl + KBUF, qr, r32, hi); MASKIF(pB0, pB1, j, 1);
                finishSM(pA0, pA1, alA, l_reg, P8); SBAR();
                SLOAD(j + 1); SBAR();
                pv_d0(o, vb0, P8); partialSM(pB0, pB1, m_reg, mnB, alB);
                __syncthreads(); SWRITE(0);
                RESC(alB); __syncthreads();
                SBAR(); qkt(pA0, pA1, Kl, qr, r32, hi); MASKIF(pA0, pA1, j + 1, 0);
                finishSM(pB0, pB1, alB, l_reg, P8); SBAR();
                SLOAD(j + 2); SBAR();
                pv_d0(o, vb0 + VBUF, P8); partialSM(pA0, pA1, m_reg, mnA, alA);
                __syncthreads(); SWRITE(1);
                RESC(alA); __syncthreads();
            }
            SBAR(); qkt(pB0, pB1, Kl + KBUF, qr, r32, hi); MASKIF(pB0, pB1, NT2 - 1, 1);
            finishSM(pA0, pA1, alA, l_reg, P8); SBAR();
            pv_d0(o, vb0, P8); partialSM(pB0, pB1, m_reg, mnB, alB);
            __syncthreads(); RESC(alB);
            finishSM(pB0, pB1, alB, l_reg, P8); SBAR();
            pv_d0(o, vb0 + VBUF, P8);
            if (hi == 0) li_l[r32] = l_reg; asm volatile("s_waitcnt lgkmcnt(0)" ::: "memory");
            float rli[16];
#pragma unroll
            for (int r = 0; r < 16; ++r) rli[r] = __builtin_amdgcn_rcpf(li_l[crow(r, hi)]);
            unsigned char* Ow = mix + (size_t)trow0 * DM + 2048 + h * 128; const unsigned lq = opq((unsigned)lane); unsigned oo = (unsigned)((wid * 32 + 4 * (lq >> 5)) * DM + (lq & 31u));
            asm volatile("" : "+v"(oo));
#pragma unroll
            for (int r = 0; r < 16; ++r) { const unsigned ro = oo + (unsigned)(((r & 3) + 8 * (r >> 2)) * DM); const float rs16 = rli[r] * 16.f;
                const unsigned w01 = __builtin_amdgcn_cvt_pk_fp8_f32(o[0][r] * rs16, o[1][r] * rs16, 0u, false), w23 = __builtin_amdgcn_cvt_pk_fp8_f32(o[2][r] * rs16, o[3][r] * rs16, 0u, false);
                stg<unsigned char>(Ow, ro, 0, (unsigned char)(w01 & 0xffu)); stg<unsigned char>(Ow, ro, 32, (unsigned char)((w01 >> 8) & 0xffu));
                stg<unsigned char>(Ow, ro, 64, (unsigned char)(w23 & 0xffu)); stg<unsigned char>(Ow, ro, 96, (unsigned char)((w23 >> 8) & 0xffu)); }
#undef SLOAD
#undef SWRITE
#undef RESC
#undef MASKIF
        }
    }
}

#define GAS __attribute__((address_space(1)))
typedef const __attribute__((address_space(4))) unsigned long long* KArgP;
DEV KArgP kargs_fresh() {
    const unsigned long long p = (unsigned long long)__builtin_amdgcn_kernarg_segment_ptr(); unsigned lo = (unsigned)p, hi = (unsigned)(p >> 32);
    asm volatile("" : "+v"(lo), "+v"(hi)); lo = __builtin_amdgcn_readfirstlane(lo); hi = __builtin_amdgcn_readfirstlane(hi);
    return (KArgP)(((unsigned long long)hi << 32) | lo);
}
#define LOADP() do { const KArgP ka_ = kargs_fresh(); F.x = (const float*)(GAS const float*)ka_[0]; F.c = (const float*)(GAS const float*)ka_[1]; F.pos = (const int*)(GAS const int*)ka_[2]; F.w_ada = (const float*)(GAS const float*)ka_[3]; F.b_ada = (const float*)(GAS const float*)ka_[4]; F.ln1_g = (const float*)(GAS const float*)ka_[5]; F.w_in = (const float*)(GAS const float*)ka_[6]; F.q_norm_g = (const float*)(GAS const float*)ka_[7]; F.kv_norm_g = (const float*)(GAS const float*)ka_[8]; F.w_uq = (const float*)(GAS const float*)ka_[9]; F.w_uk = (const float*)(GAS const float*)ka_[10]; F.w_uv = (const float*)(GAS const float*)ka_[11]; F.w_o = (const float*)(GAS const float*)ka_[12]; F.ln2_g = (const float*)(GAS const float*)ka_[13]; F.w_up = (const float*)(GAS const float*)ka_[14]; F.w_dn = (const float*)(GAS const float*)ka_[15]; F.final_g = (const float*)(GAS const float*)ka_[16]; } while (0)
constexpr int N_PHASES = 12;
__global__ void __launch_bounds__(512, 2) mk_fwd(Args args) {
    extern __shared__ __attribute__((aligned(16))) unsigned char lds_raw[];
    Frame F;
    F.lds = (LAS unsigned char*)lds_raw;
    F.tid = threadIdx.x; F.lane = F.tid & 63; F.wave = __builtin_amdgcn_readfirstlane(F.tid >> 6); F.G = gridDim.x; F.bid = blockIdx.x;
    F.x = F.c = F.w_ada = F.b_ada = F.ln1_g = F.w_in = F.q_norm_g = F.kv_norm_g = F.w_uq = F.w_uk = F.w_uv = F.w_o = F.ln2_g = F.w_up = F.w_dn = F.final_g = nullptr; F.pos = nullptr;
    F.out = args.out; F.ws = args.ws;
    volatile LAS unsigned* MISC = (volatile LAS unsigned*)(F.lds + MISC_OFF);
    if (F.tid < 32) MISC[F.tid] = 0u;
    __syncthreads();
    const int lo = args.ph_lo, hi = args.ph_hi;
    XcdBarrier bar; bar.bar = (unsigned*)(F.ws + WS_CTL) + CW_BAR; bar.x = 0; bar.st = nullptr;
    if (hi - lo > 1) bar = xcd_barrier_post((unsigned*)(F.ws + WS_CTL) + CW_BAR, MISC + 8);
#ifndef PHASE_MASK
#define PHASE_MASK 0xFFFF
#endif
#define IN(k) (((PHASE_MASK >> (k)) & 1) && lo <= (k) && (k) < hi)
#ifndef REP_PHASE
#define REP_PHASE -1
#endif
#ifndef REP_SUB
#define REP_SUB 0
#endif
#define NREP(k) ((REP_PHASE == (k)) ? 2 : 1)
#ifndef REP_BAR
#define REP_BAR 0
#endif
#define SEAM(k) do { if (IN(k) && IN((k) + 1)) { xcd_barrier(bar); if (REP_BAR) { xcd_barrier(bar); xcd_barrier(bar); } } } while (0)
    LAS unsigned char* ring = F.lds;
#define FRESH() do { unsigned lo_ = (unsigned)(unsigned long long)F.ws, hi_ = (unsigned)((unsigned long long)F.ws >> 32); asm volatile("" : "+v"(lo_), "+v"(hi_)); lo_ = __builtin_amdgcn_readfirstlane(lo_); hi_ = __builtin_amdgcn_readfirstlane(hi_); F.ws = (unsigned char*)(((unsigned long long)hi_ << 32) | lo_); } while (0)
    for (int rep_ = 0; IN(0) && rep_ < NREP(0); ++rep_) { if (rep_) __syncthreads(); LOADP(); p0_mod(F); __syncthreads(); p0_weights(F); __syncthreads(); p0_colmax(F); } SEAM(0);
    for (int rep_ = 0; IN(1) && rep_ < NREP(1); ++rep_) { if (rep_) __syncthreads(); LOADP(); p1_win(F); __syncthreads(); p_adaln<3, false>(F, F.x, F.ln1_g, 0, 1, true); } SEAM(1);
    for (int rep_ = 0; IN(2) && rep_ < NREP(2); ++rep_) { if (rep_) __syncthreads(); LOADP(); { pg8::Gemm g{wsp<unsigned char>(F, WS_H), wsp<unsigned char>(F, WS_WIN), M, NA, DM, DM, DM, 0}; pg8::StaticOrder S; S.init(M, NA, F.G, F.bid);
          pg8::EpiBf16<5> E{wsp<bf16>(F, WS_PA), NA, wsp<float>(F, WS_RSA), wsp<float>(F, WS_CSB), wsp<unsigned char>(F, WS_KAV8)}; pg8::gemm_phase<3>(ring, g, S, E); }
        { pg8::Gemm g{wsp<unsigned char>(F, WS_H), wsp<unsigned char>(F, WS_WINB), M, NBQ, DM, DM, DM, 0}; pg8::StaticOrder S; S.init(M, NBQ, F.G, F.bid);
          pg8::EpiBf16<3> E{wsp<bf16>(F, WS_PB), NBQ, wsp<float>(F, WS_RSA), wsp<float>(F, WS_CSB) + NA}; pg8::gemm_phase<3>(ring, g, S, E); } } SEAM(2);
    for (int rep_ = 0; IN(3) && rep_ < NREP(3); ++rep_) { if (rep_) __syncthreads(); LOADP(); p2_rowstats(F); } SEAM(3);
    for (int rep_ = 0; IN(4) && rep_ < NREP(4); ++rep_) { if (rep_) __syncthreads();
        { pg8::Gemm g{wsp<unsigned char>(F, WS_CQ8), wsp<unsigned char>(F, WS_WUQ), M, NQF, QLORA, QLORA, QLORA, 0}; pg8::StaticOrder S; S.init(M, NQF, F.G, F.bid);
          pg8::EpiBf16<3> E{wsp<bf16>(F, WS_QF), NQF, wsp<float>(F, WS_RSQ), wsp<float>(F, WS_CSU)}; pg8::gemm_phase<3>(ring, g, S, E); }
        { pg8::Gemm g{wsp<unsigned char>(F, WS_CKV8), wsp<unsigned char>(F, WS_WUKV), M, NKV, KVLORA, KVLORA, KVLORA, 0}; pg8::StaticOrder S; S.init(M, NKV, F.G, F.bid);
          pg8::EpiFp8Deq E{wsp<unsigned char>(F, WS_KV), NKV, wsp<float>(F, WS_RSKV), wsp<float>(F, WS_CSU) + NQF}; pg8::gemm_phase<3>(ring, g, S, E); }
        idx_phase<0>(F);
    } SEAM(4);
#ifndef P5SEL
#define P5SEL 3
#endif
    for (int rep_ = 0; IN(5) && rep_ < NREP(5); ++rep_) { if (rep_) __syncthreads(); LOADP(); sparse_phase<true>(F); __syncthreads();   mla_phase(F); } SEAM(5);
    for (int rep_ = 0; IN(7) && rep_ < NREP(7); ++rep_) { if (rep_) __syncthreads(); LOADP(); pg8::Gemm g{wsp<unsigned char>(F, WS_MIX), wsp<unsigned char>(F, WS_WO), M, DM, DM, DM, DM, 0}; pg8::StaticOrder S; S.init(M, DM, F.G, F.bid);
        pg8::EpiResGate<false> E{F.x, wsp<bf16>(F, WS_X1), DM, wsp<float>(F, WS_GATE)}; pg8::gemm_phase<true, pg8::EpiResGate<false>, pg8::StaticOrder, 0x78787878>(ring, g, S, E); } SEAM(7);
    for (int rep_ = 0; IN(8) && rep_ < NREP(8); ++rep_) { if (rep_) __syncthreads(); LOADP(); p_adaln<1, true>(F, wsp<bf16>(F, WS_X1), F.ln2_g, 3, 4, false); } SEAM(8);
    for (int rep_ = 0; IN(9) && rep_ < NREP(9); ++rep_) { if (rep_) __syncthreads(); LOADP(); pg8::Gemm g{wsp<unsigned char>(F, WS_H), wsp<unsigned char>(F, WS_WUP), M, DFF, DM, DM, DM, 0}; pg8::StaticOrder S; S.init(M, DFF, F.G, F.bid);
        pg8::EpiFp8Relu2 E{wsp<unsigned char>(F, WS_HID), DFF}; pg8::gemm_phase<true, pg8::EpiFp8Relu2, pg8::StaticOrder, 0x78787878>(ring, g, S, E); } SEAM(9);
    for (int rep_ = 0; IN(10) && rep_ < NREP(10); ++rep_) { if (rep_) __syncthreads(); LOADP(); pg8::Gemm g{wsp<unsigned char>(F, WS_HID), wsp<unsigned char>(F, WS_WDN), M, DM, DFF, DFF, DFF, 0x77777777};    pg8::StaticOrder S; S.init(M, DM, F.G, F.bid);
        pg8::EpiResGate<true> E{wsp<bf16>(F, WS_X1), wsp<bf16>(F, WS_X2), DM, wsp<float>(F, WS_GATE) + NB * DM}; pg8::gemm_phase<true, pg8::EpiResGate<true>, pg8::StaticOrder, 0x77777777>(ring, g, S, E); } SEAM(10);
    for (int rep_ = 0; IN(11) && rep_ < NREP(11); ++rep_) { if (rep_) __syncthreads(); LOADP(); p_final(F); }
#undef IN
#undef SEAM
}


#ifndef DBG
#define DBG 0
#endif
#if DBG
constexpr int DBG_ERRW = 8192;
__device__ unsigned dbg_hash(unsigned x) { x ^= x >> 16; x *= 0x7feb352du; x ^= x >> 15; x *= 0x846ca68bu; x ^= x >> 16; return x; }
__device__ float dbg_bsum(float v, float* sh) {
    __syncthreads(); sh[threadIdx.x] = v; __syncthreads();
    for (int o = 128; o > 0; o >>= 1) { if ((int)threadIdx.x < o) sh[threadIdx.x] += sh[threadIdx.x + o]; __syncthreads(); }
    const float r = sh[0]; __syncthreads(); return r;
}
__device__ float dbg_bmax(float v, float* sh) {
    __syncthreads(); sh[threadIdx.x] = v; __syncthreads();
    for (int o = 128; o > 0; o >>= 1) { if ((int)threadIdx.x < o) sh[threadIdx.x] = fmaxf(sh[threadIdx.x], sh[threadIdx.x + o]); __syncthreads(); }
    const float r = sh[0]; __syncthreads(); return r;
}
__device__ void dbg_report(unsigned* errw, float got, float ref, float S) {
    float e = fabsf(got - ref) / (fabsf(ref) + S); if (!(e == e)) e = 100.f; if (e > 100.f) e = 100.f;
    atomicMax(errw, __float_as_uint(e));
}
__global__ void __launch_bounds__(256) dbg_kernel(Args args, int which) {
    __shared__ float sh[256]; __shared__ float shv[4096];
    Frame F; F.ws = args.ws; F.out = args.out;
    const float* x = (const float*)args.in[0]; const float* c = (const float*)args.in[1]; const int* pos = (const int*)args.in[2];
    const float* w_ada = (const float*)args.in[3]; const float* b_ada = (const float*)args.in[4]; const float* ln1_g = (const float*)args.in[5]; const float* w_in = (const float*)args.in[6];
    const float* qg = (const float*)args.in[7]; const float* kvg = (const float*)args.in[8]; const float* w_uq = (const float*)args.in[9]; const float* w_uk = (const float*)args.in[10]; const float* w_uv = (const float*)args.in[11];
    unsigned* errw = (unsigned*)(args.ws + WS_CTL) + DBG_ERRW;
    const int tid = threadIdx.x; const unsigned hs = dbg_hash(blockIdx.x * 2654435761u + 12345u);
    const bf16* H = wsp<bf16>(F, WS_H); const bf16* pa = wsp<bf16>(F, WS_PA); const bf16* pb = wsp<bf16>(F, WS_PB); const bf16* qf = wsp<bf16>(F, WS_QF); const bf16* kv = wsp<bf16>(F, WS_KV);
    const unsigned char* kv8 = wsp<unsigned char>(F, WS_KV); auto f8f = [](unsigned char v) -> float { return __builtin_amdgcn_cvt_f32_fp8((int)v, 0); };
    const bf16* kro = wsp<bf16>(F, WS_KROPE); const unsigned char* mix = wsp<unsigned char>(F, WS_MIX); const float* sc = wsp<float>(F, WS_SC); const int* idx = wsp<int>(F, WS_IDX); const int* cnt = wsp<int>(F, WS_CNT);
    if (which == 1) {
        const int row = hs % M, col = dbg_hash(hs) % DM, b = row / SEQ;
        float ss = 0.f, d1 = 0.f, d0 = 0.f;
        for (int d = tid; d < DM; d += 256) { const float xv = x[(size_t)row * DM + d]; ss += xv * xv; const float cv = c[b * DM + d], sl = cv / (1.f + expf(-cv));
            d1 += sl * w_ada[(size_t)d * 6 * DM + 1 * DM + col]; d0 += sl * w_ada[(size_t)d * 6 * DM + 0 * DM + col]; }
        ss = dbg_bsum(ss, sh); d1 = dbg_bsum(d1, sh); d0 = dbg_bsum(d0, sh);
        if (tid == 0) { const float rstd = 1.f / sqrtf(ss / DM + EPS); const float ref = x[(size_t)row * DM + col] * rstd * ln1_g[col] * (1.f + d1 + b_ada[DM + col]) + d0 + b_ada[col];
            dbg_report(errw, bf2f(H[(size_t)row * DM + col]), ref, 1.f); }
    } else if (which == 2) {
        const int specials[18] = {0, 2047, 2048, 2175, 2176, 2303, 2304, 6399, 6400, 6527, 6528, 6559, 6560, 7583, 7584, 8095, 8096, 8159};
        const int row = hs % M; const int col = (blockIdx.x < 72) ? specials[blockIdx.x % 18] : (int)(dbg_hash(hs) % INW);
        float a = 0.f; { const signed char* H8i = (const signed char*)wsp<unsigned char>(F, WS_H); const float sa = wsp<float>(F, WS_RSA)[row];
          for (int d = tid; d < DM; d += 256) a += (float)H8i[(size_t)row * DM + d] * sa * w_in[(size_t)d * INW + col]; }
        a = dbg_bsum(a, sh);
        if (tid == 0) { float got;
            if (col < C_KA) got = bf2f(pb[(size_t)row * NBQ + B_QA + col]); else if (col < C_VA) got = bf2f(pa[(size_t)row * NA + A_KA + col - C_KA]); else if (col < C_QI) got = bf2f(pa[(size_t)row * NA + A_VA + col - C_VA]);
            else if (col < C_KI) got = bf2f(pa[(size_t)row * NA + A_QI + col - C_QI]); else if (col < C_WI) got = bf2f(pa[(size_t)row * NA + A_KI + col - C_KI]); else if (col < C_CQ) got = bf2f(pa[(size_t)row * NA + A_WI + col - C_WI]);
            else if (col < C_CKV) got = bf2f(pb[(size_t)row * NBQ + B_CQ + col - C_CQ]); else if (col < C_KR) got = bf2f(pa[(size_t)row * NA + A_CKV + col - C_CKV]); else got = bf2f(pa[(size_t)row * NA + A_KR + col - C_KR]);
            dbg_report(errw, got, a, 1.f); }
    } else if (which == 3) {
        const int row = hs % M; const int sel = blockIdx.x % 3;
        if (sel == 0) { const int col = dbg_hash(hs) % NQF; float ss = 0.f, a = 0.f;
            for (int r = tid; r < QLORA; r += 256) { const float v = bf2f(pb[(size_t)row * NBQ + B_CQ + r]); ss += v * v; a += v * qg[r] * w_uq[(size_t)r * NQF + col]; }
            ss = dbg_bsum(ss, sh); a = dbg_bsum(a, sh); if (tid == 0) dbg_report(errw, bf2f(qf[(size_t)row * NQF + col]), a / sqrtf(ss / QLORA + EPS), 1.f);
        } else if (sel == 1) { const int col = dbg_hash(hs) % NKV; float ss = 0.f, a = 0.f;
            for (int r = tid; r < KVLORA; r += 256) { const float v = bf2f(pa[(size_t)row * NA + A_CKV + r]); ss += v * v; a += v * kvg[r] * (col < 2048 ? w_uk[(size_t)r * 2048 + col] : w_uv[(size_t)r * 2048 + col - 2048]); }
            ss = dbg_bsum(ss, sh); a = dbg_bsum(a, sh); if (tid == 0) dbg_report(errw, f8f(kv8[(size_t)row * NKV + col]), a / sqrtf(ss / KVLORA + EPS), 1.f);
        } else { if (tid < 32) { const double inv = pow(10000.0, -(double)(2 * tid) / 64.0), ang = (double)pos[row] * inv; const float cs = (float)cos(ang), sn = (float)sin(ang);
            const float x1 = bf2f(pa[(size_t)row * NA + A_KR + tid]), x2 = bf2f(pa[(size_t)row * NA + A_KR + 32 + tid]);
            dbg_report(errw, bf2f(kro[(size_t)row * 64 + tid]), x1 * cs - x2 * sn, 1.f); dbg_report(errw, bf2f(kro[(size_t)row * 64 + 32 + tid]), x1 * sn + x2 * cs, 1.f); } }
    } else if (which == 4) {
        int t = hs % M; if (blockIdx.x < 16) t = (blockIdx.x & 3) * SEQ + (blockIdx.x >> 2) * 63 + (blockIdx.x >> 2);
        const int h = dbg_hash(hs) % 16, b = t / SEQ; const int cq = pos[t] >> 6;
        float* q = shv;
        if (tid < 192) { float v = bf2f(qf[(size_t)t * NQF + h * 192 + tid]);
            if (tid >= 128) { const int i = (tid - 128) & 31; const double inv = pow(10000.0, -(double)(2 * i) / 64.0), ang = (double)pos[t] * inv; const float cs = (float)cos(ang), sn = (float)sin(ang);
                const float x1 = bf2f(qf[(size_t)t * NQF + h * 192 + 128 + i]), x2 = bf2f(qf[(size_t)t * NQF + h * 192 + 160 + i]); v = (tid < 160) ? x1 * cs - x2 * sn : x1 * sn + x2 * cs; }
            q[tid] = v; }
        __syncthreads();
        float* scs = shv + 256;
        float mx = -1e30f;
        for (int s = tid; s < SEQ; s += 256) { if ((pos[b * SEQ + s] >> 6) <= cq) { float a = 0.f; const unsigned char* kp = kv8 + (size_t)(b * SEQ + s) * NKV + h * 128; const bf16* rp = kro + (size_t)(b * SEQ + s) * 64;
            for (int d = 0; d < 128; ++d) a += q[d] * f8f(kp[d]); for (int d = 0; d < 64; ++d) a += q[128 + d] * bf2f(rp[d]); a *= 0.07216878364870323f; mx = fmaxf(mx, a); } }
        mx = dbg_bmax(mx, sh);
        float den = 0.f; float o0 = 0.f;
        float acc = 0.f;
        for (int s0 = 0; s0 < SEQ; s0 += 256) { const int s = s0 + tid; float pw = 0.f;
            if ((pos[b * SEQ + s] >> 6) <= cq) { float a = 0.f; const unsigned char* kp = kv8 + (size_t)(b * SEQ + s) * NKV + h * 128; const bf16* rp = kro + (size_t)(b * SEQ + s) * 64;
                for (int d = 0; d < 128; ++d) a += q[d] * f8f(kp[d]); for (int d = 0; d < 64; ++d) a += q[128 + d] * bf2f(rp[d]); a *= 0.07216878364870323f; pw = expf(a - mx); }
            den += pw; __syncthreads(); scs[tid] = pw; __syncthreads();
            if (tid < 128) for (int j = 0; j < 256; ++j) { const float pj = scs[j]; if (pj != 0.f) acc += pj * f8f(kv8[(size_t)(b * SEQ + s0 + j) * NKV + 2048 + h * 128 + tid]); } }
        den = dbg_bsum(den, sh); (void)o0;
        { float en = 0.f, ed = 0.f;
          if (tid < 128) { const float got = __builtin_amdgcn_cvt_f32_fp8((int)mix[(size_t)t * DM + 2048 + h * 128 + tid], 0) * (1.f / 16.f), ref = acc / den; en = (got - ref) * (got - ref); ed = ref * ref; }
          en = dbg_bsum(en, sh); ed = dbg_bsum(ed, sh);
          if (tid == 0) { float e = sqrtf(en / (ed + 1e-12f)); if (!(e == e)) e = 100.f; atomicMax(errw, __float_as_uint(e)); } }
    } else if (which == 5) {
        const int t = hs % M, b = t / SEQ; const int tq = t % SEQ; const int s = dbg_hash(hs) % ((tq / 64 + 1) * 64);
        float a = 0.f;
        if (tid < 32) { float dot = 0.f; for (int d = 0; d < 128; ++d) dot += bf2f(pa[(size_t)t * NA + A_QI + tid * 128 + d]) * bf2f(pa[(size_t)(b * SEQ + s) * NA + A_KI + d]);
            a = bf2f(pa[(size_t)t * NA + A_WI + tid]) * fmaxf(dot, 0.f); }
        float aa = dbg_bsum(fabsf(a), sh); a = dbg_bsum(a, sh);
        if (tid == 0) { float e = fabsf(sc[(size_t)t * SEQ + s] - a) / (aa + 1e-3f); if (!(e == e)) e = 100.f; atomicMax(errw, __float_as_uint(fminf(e, 100.f))); }
    } else if (which == 6) {
        int t = hs % M; if (blockIdx.x < 16) t = (blockIdx.x & 3) * SEQ + (blockIdx.x >> 2) * 50;
        const int b = t / SEQ, cq = pos[t] >> 6; const int n = cnt[t];
        float nadm = 0.f; for (int s = tid; s < SEQ; s += 256) nadm += ((pos[b * SEQ + s] >> 6) <= cq) ? 1.f : 0.f;
        nadm = dbg_bsum(nadm, sh); const int want = (int)nadm < TOPK ? (int)nadm : TOPK;
        float bad = (n != want) ? 1.f : 0.f; float ranksum = 0.f;
        if (tid < n && n <= TOPK) { const int k = idx[(size_t)t * TOPK + tid]; if (k < 0 || k >= SEQ || (pos[b * SEQ + k] >> 6) > cq) bad = 1.f; else { const float v = sc[(size_t)t * SEQ + k]; int rank = 0;
            for (int s = 0; s < SEQ; ++s) if ((pos[b * SEQ + s] >> 6) <= cq) { const float w = sc[(size_t)t * SEQ + s]; if (w > v || (w == v && s < k)) ++rank; }
            if (rank >= n) bad = 1.f; ranksum = (float)rank; } }
        bad = dbg_bmax(bad, sh); ranksum = dbg_bsum(ranksum, sh);
        if (tid == 0) { float e = bad; if (ranksum != (float)(n * (n - 1) / 2)) e = 2.f; atomicMax(errw, __float_as_uint(e)); }
    } else if (which == 8) {
        if (blockIdx.x == 0 && tid < 64) { const int l = tid, r = l & 31, h = l >> 5;
            auto fa = [](int i, int hh, int pp) -> int { return ((i * 7 + hh * 13 + pp * 3) % 5) - 2; };
            auto fb = [](int j, int hh, int pp) -> int { return ((j * 5 + hh * 11 + pp * 7) % 7) - 3; };
            pg8::v8i A, Bq;
            for (int w = 0; w < 8; ++w) { unsigned wa = 0u, wb = 0u;
                wa = __builtin_amdgcn_cvt_pk_fp8_f32((float)fa(r, h, 4 * w), (float)fa(r, h, 4 * w + 1), wa, false); wa = __builtin_amdgcn_cvt_pk_fp8_f32((float)fa(r, h, 4 * w + 2), (float)fa(r, h, 4 * w + 3), wa, true);
                wb = __builtin_amdgcn_cvt_pk_fp8_f32((float)fb(r, h, 4 * w), (float)fb(r, h, 4 * w + 1), wb, false); wb = __builtin_amdgcn_cvt_pk_fp8_f32((float)fb(r, h, 4 * w + 2), (float)fb(r, h, 4 * w + 3), wb, true);
                A[w] = (int)wa; Bq[w] = (int)wb; }
            f32x16 d = {}; asm volatile("" : "+v"(d));
            d = __builtin_amdgcn_mfma_scale_f32_32x32x64_f8f6f4(A, Bq, d, 0, 0, 0, 0x7f7f7f7f, 0, 0x7f7f7f7f);
            float bad = 0.f;
            for (int rg = 0; rg < 16; ++rg) { const int i = (rg & 3) + 8 * (rg >> 2) + 4 * h, j = r; int ex = 0;
                for (int hh = 0; hh < 2; ++hh) for (int pp = 0; pp < 32; ++pp) ex += fa(i, hh, pp) * fb(j, hh, pp);
                if (d[rg] != (float)ex) bad = 0.1f; }
            atomicMax(errw, __float_as_uint(bad)); }
    } else if (which == 7) {
        int t = hs % M; if (blockIdx.x < 16) t = (blockIdx.x & 3) * SEQ + (blockIdx.x >> 2) * 50;
        const int h = dbg_hash(hs) % 16, b = t / SEQ, n = cnt[t]; const float slope = exp2f(-0.5f * (float)(h + 1));
        float sv = -1e30f; int k = 0;
        if (tid < n) { k = idx[(size_t)t * TOPK + tid]; float a = 0.f; for (int d = 0; d < 128; ++d) a += bf2f(pb[(size_t)t * NBQ + B_QA + h * 128 + d]) * bf2f(pa[(size_t)(b * SEQ + k) * NA + A_KA + d]);
            sv = a * 0.088388347648318440f - slope * fabsf((float)(pos[t] - pos[b * SEQ + k])); }
        const float mx = dbg_bmax(sv, sh); const float pw = (tid < n) ? expf(sv - mx) : 0.f; const float den = dbg_bsum(pw, sh);
        shv[tid] = pw; ((int*)shv)[256 + tid] = k; __syncthreads();
        { float en = 0.f, ed = 0.f;
          if (tid < 128) { float acc = 0.f; for (int j = 0; j < n; ++j) acc += shv[j] * bf2f(pa[(size_t)(b * SEQ + ((int*)shv)[256 + j]) * NA + A_VA + tid]);
              const float got = __builtin_amdgcn_cvt_f32_fp8((int)mix[(size_t)t * DM + h * 128 + tid], 0), ref = acc / den; en = (got - ref) * (got - ref); ed = ref * ref; }
          en = dbg_bsum(en, sh); ed = dbg_bsum(ed, sh);
          if (tid == 0) { float e = sqrtf(en / (ed + 1e-12f)); if (!(e == e)) e = 100.f; atomicMax(errw, __float_as_uint(e)); } }
    }
}
__global__ void dbg_apply(float* out, const unsigned* errw, size_t n) {
    const float e = __uint_as_float(errw[0]); const float f = fminf(3.f, e * 10.f);
    for (size_t i = (size_t)blockIdx.x * blockDim.x + threadIdx.x; i < n; i += (size_t)gridDim.x * blockDim.x) out[i] *= (1.f + f);
}
#ifndef DBG_HI
#define DBG_HI (DBG == 1 ? 2 : (DBG == 2 ? 3 : 7))
#endif
#endif

extern "C" void kernel_launch(void* const* d_in, const int* in_sizes, int n_in, void* d_out, int out_size, void* d_ws, size_t ws_size, hipStream_t stream) {
    static int grid = 0;
    if (grid == 0) {
        if (n_in != 17 || in_sizes[0] != M * DM || out_size != M * DM || ws_size < WS_END) {
            fprintf(stderr, "kernel_launch: shape mismatch (n_in %d, in0 %d, out %d, ws %zu; need ws >= %zu); nothing launched\n", n_in, n_in > 0 ? in_sizes[0] : -1, out_size, ws_size, (size_t)WS_END); grid = -1; return; }
        int dev = 0, cus = 0, per_cu = 0;
        if (hipGetDevice(&dev) != hipSuccess || hipDeviceGetAttribute(&cus, hipDeviceAttributeMultiprocessorCount, dev) != hipSuccess) { grid = -1; return; }
        if (hipFuncSetAttribute((const void*)mk_fwd, hipFuncAttributeMaxDynamicSharedMemorySize, LDS_BYTES) != hipSuccess) { fprintf(stderr, "kernel_launch: hipFuncSetAttribute failed\n"); grid = -1; return; }
        if (hipOccupancyMaxActiveBlocksPerMultiprocessor(&per_cu, (const void*)mk_fwd, 512, LDS_BYTES) != hipSuccess || per_cu < 1) { fprintf(stderr, "kernel_launch: occupancy query says %d blocks per CU\n", per_cu); }
        (void)hipGetLastError();
        grid = cus > 0 ? cus : 256;
    }
    if (grid < 0) return;
    (void)hipMemsetAsync((char*)d_ws + WS_CTL, 0, CTL_ZERO_BYTES, stream);
    Args a{};
    for (int i = 0; i < 17; ++i) a.in[i] = d_in[i];
    a.out = (float*)d_out; a.ws = (unsigned char*)d_ws;
#if MK_PER_PHASE
    for (int k = 0; k < N_PHASES; ++k) { a.ph_lo = k; a.ph_hi = k + 1; hipLaunchKernelGGL(mk_fwd, dim3(grid), dim3(512), LDS_BYTES, stream, a); }
#else
#if DBG
    a.ph_lo = 0; a.ph_hi = DBG_HI; hipLaunchKernelGGL(mk_fwd, dim3(grid), dim3(512), LDS_BYTES, stream, a);
    hipLaunchKernelGGL(dbg_kernel, dim3(1024), dim3(256), 0, stream, a, DBG);
    if (DBG_HI < N_PHASES) { (void)hipMemsetAsync((char*)d_ws + WS_CTL + CW_BAR * 4, 0, XCD_BAR_WORDS * 4, stream); a.ph_lo = DBG_HI; a.ph_hi = N_PHASES; hipLaunchKernelGGL(mk_fwd, dim3(grid), dim3(512), LDS_BYTES, stream, a); }
    hipLaunchKernelGGL(dbg_apply, dim3(1024), dim3(256), 0, stream, (float*)d_out, (const unsigned*)((char*)d_ws + WS_CTL) + DBG_ERRW, (size_t)M * DM);
#else
    a.ph_lo = 0; a.ph_hi = N_PHASES; hipLaunchKernelGGL(mk_fwd, dim3(grid), dim3(512), LDS_BYTES, stream, a);
#endif
#endif
    const hipError_t le = hipPeekAtLastError();
    if (le != hipSuccess) fprintf(stderr, "kernel_launch: launch failed: %s\n", hipGetErrorName(le));
}
```

```cpp
#include <hip/hip_runtime.h>
#include <cstdio>
#include <cstdint>

#ifndef MK_PER_PHASE
#define MK_PER_PHASE 0
#endif

#define DEV __device__ __forceinline__
#define LAS __attribute__((address_space(3)))
#define GAS __attribute__((address_space(1)))
typedef unsigned short bf16;
typedef short bf16x8 __attribute__((ext_vector_type(8)));
typedef short s16x4 __attribute__((ext_vector_type(4)));
typedef float f32x4 __attribute__((ext_vector_type(4)));
typedef float f32x2 __attribute__((ext_vector_type(2)));
typedef float f32x16 __attribute__((ext_vector_type(16)));
typedef unsigned u32x4 __attribute__((ext_vector_type(4)));
typedef unsigned u32x2 __attribute__((ext_vector_type(2)));
typedef int i32x4 __attribute__((ext_vector_type(4)));

constexpr int NB = 4, SEQ = 4096, DM = 4096, M = NB * SEQ;
constexpr int INW = 8160, INP = 8192;
constexpr int C_QA = 0, C_KA = 2048, C_VA = 2176, C_QI = 2304, C_KI = 6400, C_WI = 6528, C_CQ = 6560, C_CKV = 7584, C_KR = 8096;
constexpr int NA = 5120, NBQ = 3072;
constexpr int A_QI = 0, A_KI = 4096, A_WI = 4224, A_KA = 4256, A_VA = 4384, A_CKV = 4512, A_KR = 5024, A_END = 5088;
constexpr int B_QA = 0, B_CQ = 2048;
constexpr int QLORA = 1024, KVLORA = 512, NQF = 3072, NKV = 4096, DFF = 16384;
constexpr int TOPK = 256;
constexpr float EPS = 1e-6f;

constexpr size_t MiB = 1u << 20;
constexpr size_t WS_CTL = 0, CTL_ZERO_BYTES = 1 * MiB;
constexpr size_t WS_MODP = 2 * MiB;
constexpr size_t WS_GATE = 3 * MiB;
constexpr size_t WS_RSQ = 3 * MiB + 256 * 1024;
constexpr size_t WS_RSKV = 3 * MiB + 512 * 1024;
constexpr size_t WS_CK = 3 * MiB + 768 * 1024;
constexpr size_t WS_TMM = 4 * MiB - 8192;
constexpr size_t WS_CNT = 4 * MiB;
constexpr size_t WS_RSA = 4 * MiB + 256 * 1024;
constexpr size_t WS_CSB = 4 * MiB + 384 * 1024;
constexpr size_t WS_CMAXP = 4 * MiB + 448 * 1024;
constexpr size_t WS_CSU = 4 * MiB + 576 * 1024;
constexpr size_t WS_CMAXU = 4 * MiB + 640 * 1024;
constexpr size_t WS_CQ8 = 1002 * MiB, WS_CKV8 = 1018 * MiB;
constexpr size_t WS_COS = 5 * MiB, WS_SIN = 7 * MiB;
constexpr size_t WS_KROPE = 9 * MiB;
constexpr size_t WS_KROPE8 = 12 * MiB;
constexpr size_t WS_IDX = 16 * MiB;
constexpr size_t WS_WIN = 32 * MiB;
constexpr size_t WS_WUQ = 96 * MiB;
constexpr size_t WS_WUKV = 102 * MiB;
constexpr size_t WS_WO = 106 * MiB;
constexpr size_t WS_WUP = 138 * MiB;
constexpr size_t WS_WDN = 266 * MiB;
constexpr size_t WS_H = 394 * MiB;
constexpr size_t WS_PROJ = 522 * MiB;
constexpr size_t WS_PA = WS_PROJ, WS_PB = WS_PROJ + 160 * MiB;
constexpr size_t WS_WINB = 32 * MiB + 40 * MiB;
constexpr size_t WS_QF = 778 * MiB;
constexpr size_t WS_X1 = 874 * MiB;
constexpr size_t WS_X2 = 1130 * MiB;
constexpr size_t WS_H8 = WS_QF;
constexpr size_t WS_KAV8 = 940 * MiB;
constexpr size_t WS_KV = 874 * MiB;
constexpr size_t WS_MIX = 1002 * MiB;
constexpr size_t WS_SC = 1130 * MiB;
constexpr size_t WS_HID = 522 * MiB;
constexpr size_t WS_END = 1386 * MiB;

constexpr int CW_BAR = 4096;

constexpr int RING_BYTES = 131072;
constexpr int MISC_OFF = 140000;
constexpr int LDS_BYTES = 147456;

DEV unsigned f2bf(float f) { unsigned u = __builtin_bit_cast(unsigned, f); return (u + 0x7fffu + ((u >> 16) & 1u)) >> 16; }
DEV unsigned pk2(float lo, float hi) { return f2bf(lo) | (f2bf(hi) << 16); }
DEV float bf2f(unsigned short b) { return __builtin_bit_cast(float, ((unsigned)b) << 16); }
DEV float bflo(unsigned w) { return __builtin_bit_cast(float, w << 16); }
DEV float bfhi(unsigned w) { return __builtin_bit_cast(float, w & 0xffff0000u); }
DEV unsigned cvt_pk_bf16(float lo, float hi) { unsigned r; asm volatile("v_cvt_pk_bf16_f32 %0, %1, %2" : "=v"(r) : "v"(lo), "v"(hi)); return r; }
DEV float wave_sum(float v) {
#pragma unroll
    for (int o = 1; o < 64; o <<= 1) v += __shfl_xor(v, o);
    return v;
}
DEV int wave_max_i(int v) {
#pragma unroll
    for (int o = 1; o < 64; o <<= 1) { int t = __shfl_xor(v, o); v = t > v ? t : v; }
    return v;
}
DEV int wave_min_i(int v) {
#pragma unroll
    for (int o = 1; o < 64; o <<= 1) { int t = __shfl_xor(v, o); v = t < v ? t : v; }
    return v;
}
template <class T> DEV T ldg(const void* base, unsigned byteoff, size_t imm = 0) { return *(const T*)((const char*)base + (size_t)byteoff + imm); }
template <class T> DEV void stg(void* base, unsigned byteoff, size_t imm, T v) { *(T*)((char*)base + (size_t)byteoff + imm) = v; }
DEV unsigned opq(unsigned v) { asm volatile("" : "+v"(v)); return v; }
DEV int floordiv64(int p) { return p >> 6; }
#define LDS_WAIT() asm volatile("s_waitcnt lgkmcnt(0)" ::: "memory")
#define VM_WAIT() asm volatile("s_waitcnt vmcnt(0)" ::: "memory")
#define SBAR() __builtin_amdgcn_sched_barrier(0)

namespace pg8 {
#define PG8_LAS __attribute__((address_space(3)))
constexpr int BM = 256, BK = 64, HALF = 128, HTB = HALF * BK * 2, STAGE_BYTES = 8 * HTB, NXCD = 8, WGM = 8;
__host__ __device__ __forceinline__ int lds_byte(int r, int c) { const int st = (r >> 4) * 2 + (c >> 5), rr = r & 15, cc = c & 31, ob = rr * 64 + cc * 2; return st * 1024 + (ob ^ (((ob >> 9) & 1) << 5)); }
__host__ __device__ __forceinline__ void stage_rc(int b, int& R, int& C) { const int st = b / 1024, sb = b % 1024, swz = sb ^ (((sb >> 9) & 1) << 5); R = (st >> 1) * 16 + swz / 64; C = (st & 1) * 32 + (swz % 64) / 2; }
__host__ __device__ __forceinline__ int perm32(int rho) { const int n = rho >> 4, i = rho & 15; return 8 * (i >> 2) + 4 * n + (i & 3); }
struct Unit { int pm, pn; };
typedef int v8i __attribute__((ext_vector_type(8)));
DEV v8i cat8(bf16x8 lo, bf16x8 hi) { typedef int v4i __attribute__((ext_vector_type(4))); const v4i a = __builtin_bit_cast(v4i, lo), b = __builtin_bit_cast(v4i, hi); return (v8i){a.x, a.y, a.z, a.w, b.x, b.y, b.z, b.w}; }
struct Gemm { const void* A; const void* Bt; int M, N, Kb, lda, ldb; int scaleB; };
struct StaticOrder {
    int nM, nN, nwg, G, c, probe, wgm;
    __host__ __device__ void init(int M_, int N_, int G_, int c_, int wgm_ = 4) { nM = M_ / BM; nN = N_ / BM; nwg = nM * nN; G = G_; c = c_; probe = 0; wgm = wgm_; }
    __host__ __device__ bool next(int i, Unit& u) const {
        const long L = (long)i * G + c; if (L >= nwg) return false;
        if (probe) { u.pm = (c >> 3) & 1; u.pn = 0; return true; }
        int wgid = (int)L; { const int q = nwg / NXCD, r = nwg % NXCD, xcd = wgid % NXCD, off = wgid / NXCD; wgid = (xcd < r ? xcd * (q + 1) : r * (q + 1) + (xcd - r) * q) + off; }
        const int nig = wgm * nN, gid = wgid / nig, fm = gid * wgm, gsz = (nM - fm) < wgm ? (nM - fm) : wgm;
        u.pm = fm + ((wgid % nig) % gsz); u.pn = (wgid % nig) / gsz; return true;
    }
    DEV void a_ready(const Unit&) const {}
    DEV void done(const Unit&) const {}
};
DEV unsigned pk4_fp8(float a, float b, float c, float d) { unsigned w; asm("" : "=v"(w));
    w = __builtin_amdgcn_cvt_pk_fp8_f32(a, b, w, false); w = __builtin_amdgcn_cvt_pk_fp8_f32(c, d, w, true); return w; }
template <int MODE> struct EpiBf16 {
    static constexpr bool PERM = true;
    bf16* O; int ldc; const float* rs; const float* cs; unsigned char* side8 = nullptr;
    DEV void operator()(const f32x4 (&acc)[2][2][4][2], const Unit& u, int, int, int, int) const {
        const unsigned tz = opq(threadIdx.x); const int fr = tz & 15, fq = (tz >> 4) & 3, wc = (tz >> 6) & 3, wr = tz >> 8;
        const int row0 = u.pm * BM + wr * 64 + fr; const int col0 = u.pn * BM + wc * 32 + 8 * fq;
#pragma unroll
        for (int ai = 0; ai < 2; ++ai)
#pragma unroll
            for (int m = 0; m < 4; ++m) { const int row = row0 + ai * HALF + m * 16; bf16* rowp = O + (size_t)row * ldc + col0;
                float sc = 1.f; if (MODE == 1 || MODE == 3 || MODE == 5) sc = rs[row];
#pragma unroll
                for (int bj = 0; bj < 2; ++bj) { f32x4 v0 = acc[ai][bj][m][0], v1 = acc[ai][bj][m][1];
                    if (MODE == 1) { v0 = v0 * sc; v1 = v1 * sc; }
                    if (MODE == 3 || MODE == 5) { const i32x4 i0 = __builtin_bit_cast(i32x4, v0), i1 = __builtin_bit_cast(i32x4, v1); const f32x4 c0 = *(const f32x4*)(cs + col0 + bj * HALF), c1 = *(const f32x4*)(cs + col0 + bj * HALF + 4);
                        v0 = (f32x4){(float)i0.x, (float)i0.y, (float)i0.z, (float)i0.w} * c0 * sc; v1 = (f32x4){(float)i1.x, (float)i1.y, (float)i1.z, (float)i1.w} * c1 * sc; }
                    if (MODE == 2) {
#pragma unroll
                        for (int j = 0; j < 4; ++j) { float a = fmaxf(v0[j], 0.f), b = fmaxf(v1[j], 0.f); v0[j] = a * a; v1[j] = b * b; } }
                    u32x4 w; w.x = cvt_pk_bf16(v0[0], v0[1]); w.y = cvt_pk_bf16(v0[2], v0[3]); w.z = cvt_pk_bf16(v1[0], v1[1]); w.w = cvt_pk_bf16(v1[2], v1[3]);
                    *(u32x4*)(rowp + bj * HALF) = w;
                    if (MODE == 5) { const int c_ = col0 + bj * HALF - A_KA;
                        if ((unsigned)c_ < 256u) { u32x2 w8; w8.x = pk4_fp8(v0[0], v0[1], v0[2], v0[3]); w8.y = pk4_fp8(v1[0], v1[1], v1[2], v1[3]); *(u32x2*)(side8 + (size_t)row * 256 + c_) = w8; } } } }
    }
};
struct EpiFp8Relu2 {
    static constexpr bool PERM = true;
    unsigned char* O; int ldc;
    DEV void operator()(const f32x4 (&acc)[2][2][4][2], const Unit& u, int, int, int, int) const {
        const unsigned tz = opq(threadIdx.x); const int fr = tz & 15, fq = (tz >> 4) & 3, wc = (tz >> 6) & 3, wr = tz >> 8;
        const int row0 = u.pm * BM + wr * 64 + fr; const int col0 = u.pn * BM + wc * 32 + 8 * fq;
#pragma unroll
        for (int ai = 0; ai < 2; ++ai)
#pragma unroll
            for (int m = 0; m < 4; ++m) { unsigned char* rowp = O + (size_t)(row0 + ai * HALF + m * 16) * ldc + col0;
#pragma unroll
                for (int bj = 0; bj < 2; ++bj) { f32x4 v0 = acc[ai][bj][m][0], v1 = acc[ai][bj][m][1];
#pragma unroll
                    for (int j = 0; j < 4; ++j) { const float a = fmaxf(v0[j], 0.f), b = fmaxf(v1[j], 0.f); v0[j] = fminf(a * a, 448.f); v1[j] = fminf(b * b, 448.f); }
                    u32x2 w; w.x = pk4_fp8(v0[0], v0[1], v0[2], v0[3]); w.y = pk4_fp8(v1[0], v1[1], v1[2], v1[3]);
                    *(u32x2*)(rowp + bj * HALF) = w; } }
    }
};
struct EpiFp8Deq {
    static constexpr bool PERM = true;
    unsigned char* O; int ldc; const float* rs; const float* cs;
    DEV void operator()(const f32x4 (&acc)[2][2][4][2], const Unit& u, int, int, int, int) const {
        const unsigned tz = opq(threadIdx.x); const int fr = tz & 15, fq = (tz >> 4) & 3, wc = (tz >> 6) & 3, wr = tz >> 8;
        const int row0 = u.pm * BM + wr * 64 + fr; const int col0 = u.pn * BM + wc * 32 + 8 * fq;
#pragma unroll
        for (int ai = 0; ai < 2; ++ai)
#pragma unroll
            for (int m = 0; m < 4; ++m) { const int row = row0 + ai * HALF + m * 16; unsigned char* rowp = O + (size_t)row * ldc + col0; const float sc = rs[row];
#pragma unroll
                for (int bj = 0; bj < 2; ++bj) { const i32x4 i0 = __builtin_bit_cast(i32x4, acc[ai][bj][m][0]), i1 = __builtin_bit_cast(i32x4, acc[ai][bj][m][1]);
                    const f32x4 c0 = *(const f32x4*)(cs + col0 + bj * HALF), c1 = *(const f32x4*)(cs + col0 + bj * HALF + 4);
                    const f32x4 v0 = (f32x4){(float)i0.x, (float)i0.y, (float)i0.z, (float)i0.w} * c0 * sc, v1 = (f32x4){(float)i1.x, (float)i1.y, (float)i1.z, (float)i1.w} * c1 * sc;
                    u32x2 w; w.x = pk4_fp8(v0[0], v0[1], v0[2], v0[3]); w.y = pk4_fp8(v1[0], v1[1], v1[2], v1[3]);
                    *(u32x2*)(rowp + bj * HALF) = w; } }
    }
};
template <bool BASE_BF16> struct EpiResGate {
    static constexpr bool PERM = true;
    const void* base; bf16* out; int ldc; const float* gate;
    DEV void operator()(const f32x4 (&acc)[2][2][4][2], const Unit& u, int, int, int, int) const {
        const unsigned tz = opq(threadIdx.x); const int fr = tz & 15, fq = (tz >> 4) & 3, wc = (tz >> 6) & 3, wr = tz >> 8;
        const int row0 = u.pm * BM + wr * 64 + fr, col0 = u.pn * BM + wc * 32 + 8 * fq;
        const float* gp = gate + (size_t)((u.pm * BM) / SEQ) * ldc + col0;
#pragma unroll
        for (int ai = 0; ai < 2; ++ai)
#pragma unroll
            for (int m = 0; m < 4; ++m) { const size_t off = (size_t)(row0 + ai * HALF + m * 16) * ldc + col0;
#pragma unroll
                for (int bj = 0; bj < 2; ++bj) { f32x4 b0, b1; f32x4 gv[2][2]; gv[bj][0] = *(const f32x4*)(gp + bj * HALF); gv[bj][1] = *(const f32x4*)(gp + bj * HALF + 4);
                    if (BASE_BF16) { const u32x4 w = *(const u32x4*)((const bf16*)base + off + bj * HALF); b0 = (f32x4){bflo(w.x), bfhi(w.x), bflo(w.y), bfhi(w.y)}; b1 = (f32x4){bflo(w.z), bfhi(w.z), bflo(w.w), bfhi(w.w)}; }
                    else { b0 = *(const f32x4*)((const float*)base + off + bj * HALF); b1 = *(const f32x4*)((const float*)base + off + bj * HALF + 4); }
                    const f32x4 r0 = b0 + gv[bj][0] * acc[ai][bj][m][0], r1 = b1 + gv[bj][1] * acc[ai][bj][m][1];
                    u32x4 o; o.x = cvt_pk_bf16(r0[0], r0[1]); o.y = cvt_pk_bf16(r0[2], r0[3]); o.z = cvt_pk_bf16(r1[0], r1[1]); o.w = cvt_pk_bf16(r1[2], r1[3]);
                    *(u32x4*)(out + off + bj * HALF) = o; }
                asm volatile("" ::: "memory"); }
    }
};

template <int FP8  , class Epi, class Sched, int SCALEB = 0x7f7f7f7f, bool ALIGN_EPI = true>
DEV void gemm_phase(PG8_LAS unsigned char* lds, const Gemm g, const Sched& S, const Epi& E) {
    const int tid = threadIdx.x, wid = __builtin_amdgcn_readfirstlane(tid >> 6), lane = tid & 63, wr = wid >> 2, wc = wid & 3, fr = lane & 15, fq = lane >> 4;
    const int nt = g.Kb / 128;
    unsigned voffA[2], voffB[2];
#pragma unroll
    for (int i = 0; i < 2; ++i) { int R, C; stage_rc(tid * 16 + i * 8192, R, C); const int Rb = Epi::PERM ? ((R & ~31) + perm32(R & 31)) : R;
        voffA[i] = (unsigned)(R * g.lda + C * 2); voffB[i] = (unsigned)(Rb * g.ldb + C * 2); }
    const size_t kstep = (size_t)(BK * 2);
    const size_t hstepA = (size_t)HALF * g.lda, hstepB = (size_t)HALF * g.ldb;
    const size_t tstepA = 2 * hstepA, tstepB = 2 * hstepB;
    const unsigned ldsw = (unsigned)wid * 1024u;
    const int aoff = lds_byte(wr * 64 + fr, fq * 8), boff = lds_byte(wc * 32 + fr, fq * 8);
#define PG8_SA(b, h) (((b) * 2 + (h)) * HTB)
#define PG8_SB(b, h) ((4 + (b) * 2 + (h)) * HTB)
#define PG8_STAGE(bufoff, gbase, voff) do { _Pragma("unroll") for (int _i = 0; _i < 2; ++_i) \
        __builtin_amdgcn_global_load_lds((const unsigned*)((const char*)(gbase) + (FP8 ? opq((voff)[_i]) : (voff)[_i])), (PG8_LAS unsigned*)(lds + (bufoff) + ldsw + _i * 8192), 16, 0, 0); } while (0)
#define PG8_LDA(dst, b, h) do { _Pragma("unroll") for (int m = 0; m < 4; ++m) _Pragma("unroll") for (int k = 0; k < 2; ++k) dst[m][k] = *(const PG8_LAS bf16x8*)(lds + PG8_SA(b, h) + aoff + m * 2048 + k * 1024); } while (0)
#define PG8_LDB(dst, b, h) do { _Pragma("unroll") for (int n = 0; n < 2; ++n) _Pragma("unroll") for (int k = 0; k < 2; ++k) dst[n][k] = *(const PG8_LAS bf16x8*)(lds + PG8_SB(b, h) + boff + n * 2048 + k * 1024); } while (0)
#define PG8_MMA(ai, bj, At, Bt) do { __builtin_amdgcn_s_setprio(1); _Pragma("unroll") for (int m = 0; m < 4; ++m) _Pragma("unroll") for (int n = 0; n < 2; ++n) { \
        if constexpr (FP8 == 1) { acc[ai][bj][m][n] = __builtin_amdgcn_mfma_scale_f32_16x16x128_f8f6f4(cat8(Bt[n][0], Bt[n][1]), cat8(At[m][0], At[m][1]), acc[ai][bj][m][n], 0, 0, 0, SCALEB, 0, 0x7f7f7f7f); } \
        else if constexpr (FP8 == 3) { _Pragma("unroll") for (int k = 0; k < 2; ++k) acc[ai][bj][m][n] = __builtin_bit_cast(f32x4, __builtin_amdgcn_mfma_i32_16x16x64_i8(__builtin_bit_cast(i32x4, Bt[n][k]), __builtin_bit_cast(i32x4, At[m][k]), __builtin_bit_cast(i32x4, acc[ai][bj][m][n]), 0, 0, 0)); } \
        else { _Pragma("unroll") for (int k = 0; k < 2; ++k) acc[ai][bj][m][n] = __builtin_amdgcn_mfma_f32_16x16x32_bf16(Bt[n][k], At[m][k], acc[ai][bj][m][n], 0, 0, 0); } } \
        __builtin_amdgcn_s_setprio(0); } while (0)
#define PG8_WAIT_V(n) asm volatile("s_waitcnt vmcnt(" #n ")" ::: "memory")
#define PG8_WAIT_L(n) asm volatile("s_waitcnt lgkmcnt(" #n ")" ::: "memory")
#define PG8_BAR __builtin_amdgcn_s_barrier()
#define PG8_SCHED __builtin_amdgcn_sched_barrier(0)
    Unit cur, nxt; int ui = 0;
    if (!S.next(0, cur)) return;
    f32x4 acc[2][2][4][2];
#pragma unroll
    for (int a = 0; a < 2; ++a)
#pragma unroll
        for (int b = 0; b < 2; ++b)
#pragma unroll
            for (int m = 0; m < 4; ++m)
#pragma unroll
                for (int n = 0; n < 2; ++n) acc[a][b][m][n] = (f32x4){0.f, 0.f, 0.f, 0.f};
    bf16x8 At[4][2], B0[2][2], B1[2][2];
    const char* cA = (const char*)g.A + (size_t)cur.pm * tstepA; const char* cB = (const char*)g.Bt + (size_t)cur.pn * tstepB;
    S.a_ready(cur);
    PG8_STAGE(PG8_SB(0, 0), cB, voffB); PG8_STAGE(PG8_SB(0, 1), cB + hstepB, voffB); PG8_STAGE(PG8_SA(0, 0), cA, voffA); PG8_STAGE(PG8_SA(0, 1), cA + hstepA, voffA);
    if (wr == 1) PG8_BAR;
    PG8_WAIT_V(2); PG8_BAR;
    PG8_STAGE(PG8_SB(1, 0), cB + kstep, voffB); PG8_STAGE(PG8_SA(1, 0), cA + kstep, voffA); PG8_STAGE(PG8_SB(1, 1), cB + hstepB + kstep, voffB);
    PG8_WAIT_V(6); PG8_BAR;
    for (;;) {
        const bool has_next = S.next(ui + 1, nxt);
        const char* nA = has_next ? (const char*)g.A + (size_t)nxt.pm * tstepA : cA; const char* nB = has_next ? (const char*)g.Bt + (size_t)nxt.pn * tstepB : cB;
        for (int t = 0; t < nt; t += 2) {
            const bool last = (t == nt - 2);
            const char* a1 = cA + (size_t)(t + 1) * kstep;
            const char* a2 = last ? nA : cA + (size_t)(t + 2) * kstep; const char* b2 = last ? nB : cB + (size_t)(t + 2) * kstep;
            const char* a3 = a2 + kstep; const char* b3 = b2 + kstep;
            if (last && has_next) S.a_ready(nxt);
            PG8_LDB(B0, 0, 0); PG8_LDB(B1, 0, 1); PG8_SCHED; PG8_LDA(At, 0, 0); PG8_STAGE(PG8_SA(1, 1), a1 + hstepA, voffA);
            PG8_WAIT_V(8); PG8_WAIT_L(0); PG8_BAR; PG8_MMA(0, 0, At, B0); PG8_MMA(0, 1, At, B1); PG8_BAR; PG8_SCHED;
            PG8_LDA(At, 0, 1); PG8_STAGE(PG8_SB(0, 0), b2, voffB); PG8_STAGE(PG8_SB(0, 1), b2 + hstepB, voffB); PG8_STAGE(PG8_SA(0, 0), a2, voffA);
            PG8_WAIT_V(8); PG8_WAIT_L(0); PG8_BAR; PG8_MMA(1, 0, At, B0); PG8_MMA(1, 1, At, B1); PG8_BAR; PG8_SCHED;
            PG8_LDB(B0, 1, 0); PG8_LDB(B1, 1, 1); PG8_SCHED; PG8_LDA(At, 1, 0); PG8_STAGE(PG8_SA(0, 1), a2 + hstepA, voffA);
            PG8_WAIT_V(8); PG8_WAIT_L(0); PG8_BAR; PG8_MMA(0, 0, At, B0); PG8_MMA(0, 1, At, B1); PG8_BAR; PG8_SCHED;
            PG8_LDA(At, 1, 1); PG8_STAGE(PG8_SB(1, 0), b3, voffB); PG8_STAGE(PG8_SB(1, 1), b3 + hstepB, voffB); PG8_STAGE(PG8_SA(1, 0), a3, voffA);
            PG8_WAIT_V(8); PG8_WAIT_L(0); PG8_BAR; PG8_MMA(1, 0, At, B0); PG8_MMA(1, 1, At, B1); PG8_BAR; PG8_SCHED;
        }
        if constexpr (ALIGN_EPI) { if (wr == 0) PG8_BAR; }
        E(acc, cur, wr, wc, fr, fq); S.done(cur);
        if (!has_next) break;
#pragma unroll
        for (int a = 0; a < 2; ++a)
#pragma unroll
            for (int b = 0; b < 2; ++b)
#pragma unroll
                for (int m = 0; m < 4; ++m)
#pragma unroll
                    for (int n = 0; n < 2; ++n) acc[a][b][m][n] = (f32x4){0.f, 0.f, 0.f, 0.f};
        cur = nxt; cA = nA; cB = nB; ++ui;
        if constexpr (ALIGN_EPI) { if (wr == 1) PG8_BAR; }
    }
    PG8_WAIT_V(0);
    if constexpr (!ALIGN_EPI) { if (wr == 0) PG8_BAR; }
    PG8_BAR;
#undef PG8_SA
#undef PG8_SB
#undef PG8_STAGE
#undef PG8_LDA
#undef PG8_LDB
#undef PG8_MMA
#undef PG8_WAIT_V
#undef PG8_WAIT_L
#undef PG8_BAR
#undef PG8_SCHED
}
}

#define XB_TMO      128
#define XB_XCNT(j)  (256  + 64 * (j))
#define XB_XSUB(j)  (1280 + 64 * (j))
#define XB_XGEN(j)  (2304 + 64 * (j))
#define XB_TOP      3328
#define XB_TOPGEN   3392
#define XCD_BAR_WORDS 3456
#define XB_SPIN_CAP (1u << 22)
DEV unsigned xb_ld(unsigned* p)              { return __hip_atomic_load(p, __ATOMIC_RELAXED, __HIP_MEMORY_SCOPE_AGENT); }
DEV unsigned xb_add(unsigned* p, unsigned v) { return __hip_atomic_fetch_add(p, v, __ATOMIC_RELAXED, __HIP_MEMORY_SCOPE_AGENT); }
DEV unsigned xb_xcc_id() { return (unsigned)__builtin_amdgcn_s_getreg((3 << 11) | 20) & 0xFu; }
#define XB_SPIN(cond, bar) do { unsigned _sp = 0; while (cond) { __builtin_amdgcn_s_sleep(1); \
    if ((++_sp & 255u) == 0u) { if (xb_ld(&(bar)[XB_TMO])) break; if (_sp > XB_SPIN_CAP) { atomicAdd(&(bar)[XB_TMO], 1u); break; } } } } while (0)
struct XcdBarrier { unsigned* bar; unsigned x; volatile LAS unsigned* st; };
DEV XcdBarrier xcd_barrier_post(unsigned* bar, volatile LAS unsigned* st) {
    XcdBarrier b; b.bar = bar; b.x = xb_xcc_id(); b.st = st;
    if (threadIdx.x == 0) (void)xb_add(&bar[XB_XCNT(b.x)], 1u);
    return b;
}
DEV void xcd_barrier_complete(unsigned* bar, unsigned x, unsigned& nloc, unsigned& nx) {
    const unsigned G = gridDim.x * gridDim.y * gridDim.z;
    unsigned sum, cnt, mine, sp = 0u;
    for (;;) {
        sum = 0u; cnt = 0u; mine = 0u;
#pragma unroll
        for (unsigned j = 0; j < 16; ++j) { const unsigned c = xb_ld(&bar[XB_XCNT(j)]); sum += c; cnt += (c > 0u) ? 1u : 0u; mine = (j == x) ? c : mine; }
        if (sum == G) break;
        __builtin_amdgcn_s_sleep(1);
        if ((++sp & 255u) == 0u) { if (xb_ld(&bar[XB_TMO])) break; if (sp > XB_SPIN_CAP) { atomicAdd(&bar[XB_TMO], 1u); break; } }
    }
    nloc = mine > 0u ? mine : 1u; nx = cnt > 0u ? cnt : 1u;
}
DEV void xcd_barrier(const XcdBarrier& b) {
    asm volatile("s_waitcnt vmcnt(0)" ::: "memory");
    __syncthreads();
    if (threadIdx.x == 0) {
        unsigned* bar = b.bar;
        __builtin_amdgcn_s_waitcnt(0);
        unsigned nloc = b.st[0], nx = b.st[1];
        if (nloc == 0u) { xcd_barrier_complete(bar, b.x, nloc, nx); b.st[0] = nloc; b.st[1] = nx; }
        const unsigned old = xb_add(&bar[XB_XSUB(b.x)], 1u);
        const unsigned gen = old / nloc;
        if (old + 1u == (gen + 1u) * nloc) {
            __builtin_amdgcn_fence(__ATOMIC_RELEASE, "agent");
            asm volatile("s_waitcnt vmcnt(0)" ::: "memory");
            const unsigned og = xb_add(&bar[XB_TOP], 1u);
            const unsigned tg = og / nx;
            if (og + 1u == (tg + 1u) * nx) xb_add(&bar[XB_TOPGEN], 1u);
            else XB_SPIN(xb_ld(&bar[XB_TOPGEN]) == tg, bar);
            __builtin_amdgcn_fence(__ATOMIC_ACQUIRE, "agent");
            xb_add(&bar[XB_XGEN(b.x)], 1u);
            asm volatile("s_waitcnt vmcnt(0)" ::: "memory");
        } else {
            XB_SPIN(xb_ld(&bar[XB_XGEN(b.x)]) == gen, bar);
            __builtin_amdgcn_fence(__ATOMIC_ACQUIRE, "agent");
            asm volatile("s_waitcnt vmcnt(0)" ::: "memory");
        }
    }
    __syncthreads();
}

struct Args { const void* in[17]; float* out; unsigned char* ws; int ph_lo, ph_hi; };
struct Frame {
    LAS unsigned char* lds;
    int tid, lane, wave, G, bid;
    const float *x, *c, *w_ada, *b_ada, *ln1_g, *w_in, *q_norm_g, *kv_norm_g, *w_uq, *w_uk, *w_uv, *w_o, *ln2_g, *w_up, *w_dn, *final_g;
    const int* pos;
    float* out; unsigned char* ws;
};
template <class T> DEV T* wsp(const Frame& F, size_t off) { return (T*)(F.ws + off); }

DEV void p0_mod(const Frame& F) {
    LAS float* sc = (LAS float*)F.lds;
    LAS float* red = (LAS float*)(F.lds + 65536);
    for (int i = F.tid; i < NB * DM; i += 512) { const float v = F.c[i]; sc[i] = v / (1.f + __expf(-v)); }
    __syncthreads();
    float* modp = wsp<float>(F, WS_MODP);
    const int cg = F.tid & 15, rg = F.tid >> 4;
    for (int item = F.bid; item < 768; item += F.G) {
        const int cc = item >> 1, half = item & 1;
        const float* wp = F.w_ada + (size_t)(half * 2048 + rg) * (6 * DM) + cc * 64 + cg * 4;
        f32x4 a0 = {0.f, 0.f, 0.f, 0.f}, a1 = a0, a2 = a0, a3 = a0;
#pragma unroll 16
        for (int i = 0; i < 64; ++i) {
            const f32x4 w = *(const f32x4*)(wp + (size_t)i * 32 * (6 * DM));
            const int r = half * 2048 + rg + 32 * i;
            a0 += w * sc[r]; a1 += w * sc[DM + r]; a2 += w * sc[2 * DM + r]; a3 += w * sc[3 * DM + r];
        }
        *(LAS f32x4*)&red[(rg * 4 + 0) * 64 + cg * 4] = a0; *(LAS f32x4*)&red[(rg * 4 + 1) * 64 + cg * 4] = a1;
        *(LAS f32x4*)&red[(rg * 4 + 2) * 64 + cg * 4] = a2; *(LAS f32x4*)&red[(rg * 4 + 3) * 64 + cg * 4] = a3;
        __syncthreads();
        if (F.tid < 256) { const int b = F.tid >> 6, col = F.tid & 63; float s = 0.f;
#pragma unroll 8
            for (int r2 = 0; r2 < 32; ++r2) s += red[(r2 * 4 + b) * 64 + col];
            modp[(size_t)(half * 4 + b) * (6 * DM) + cc * 64 + col] = s; }
        __syncthreads();
    }
}
template <bool SCALE>
DEV void p0_transpose_item(const float* W, int K, int N, bf16* WT, const float* ks, LAS float* scr, int item, int lane, int dn0 = -1) {
    const int nblk = N / 32, kb = item / nblk, nb = item % nblk, k0 = 64 * kb, n0 = 32 * nb; if (dn0 < 0) dn0 = n0;
#pragma unroll
    for (int i = 0; i < 32; ++i) { const int kk = 2 * i + (lane >> 5); float v = W[(size_t)(k0 + kk) * N + n0 + (lane & 31)]; if (SCALE) v *= ks[k0 + kk]; scr[kk * 33 + (lane & 31)] = v; }
    LDS_WAIT(); asm volatile("" ::: "memory");
    const int c = lane & 7;
#pragma unroll
    for (int j = 0; j < 4; ++j) { const int n = (lane >> 3) + 8 * j; const LAS float* s = scr + (8 * c) * 33 + n;
        u32x4 o; o.x = pk2(s[0 * 33], s[1 * 33]); o.y = pk2(s[2 * 33], s[3 * 33]); o.z = pk2(s[4 * 33], s[5 * 33]); o.w = pk2(s[6 * 33], s[7 * 33]);
        *(u32x4*)(WT + (size_t)(dn0 + n) * K + k0 + 8 * c) = o; }
    LDS_WAIT(); asm volatile("" ::: "memory");
}
DEV void p0_transpose_item_fp8(const float* W, int K, int N, unsigned char* WT, float scale, LAS float* scr, int item, int lane, int dn0 = -1) {
    const int nblk = N / 32, kb = item / nblk, nb = item % nblk, k0 = 64 * kb, n0 = 32 * nb; if (dn0 < 0) dn0 = n0;
#pragma unroll
    for (int i = 0; i < 32; ++i) { const int kk = 2 * i + (lane >> 5); scr[kk * 33 + (lane & 31)] = W[(size_t)(k0 + kk) * N + n0 + (lane & 31)] * scale; }
    LDS_WAIT(); asm volatile("" ::: "memory");
    const int c = lane & 7;
#pragma unroll
    for (int j = 0; j < 4; ++j) { const int n = (lane >> 3) + 8 * j; const LAS float* s = scr + (8 * c) * 33 + n;
        u32x2 o; o.x = pg8::pk4_fp8(s[0 * 33], s[1 * 33], s[2 * 33], s[3 * 33]); o.y = pg8::pk4_fp8(s[4 * 33], s[5 * 33], s[6 * 33], s[7 * 33]);
        *(u32x2*)(WT + (size_t)(dn0 + n) * K + k0 + 8 * c) = o; }
    LDS_WAIT(); asm volatile("" ::: "memory");
}
DEV void p0_colmax(const Frame& F) {
    LAS float* red = (LAS float*)F.lds;
    float* cm = wsp<float>(F, WS_CMAXP);
    const int cg = F.tid & 7, rg = F.tid >> 3;
    for (int item = F.bid; item < 2 * (INW / 32); item += F.G) {
        const int cc = item >> 1, half = item & 1;
        const float* wp = F.w_in + (size_t)(half * 2048 + rg) * INW + cc * 32 + cg * 4;
        f32x4 mx = {0.f, 0.f, 0.f, 0.f};
#pragma unroll 8
        for (int i = 0; i < 32; ++i) { const f32x4 w = *(const f32x4*)(wp + (size_t)i * 64 * INW); mx = __builtin_elementwise_max(mx, __builtin_elementwise_abs(w)); }
        __syncthreads();
        *(LAS f32x4*)&red[rg * 32 + cg * 4] = mx;
        __syncthreads();
        if (F.tid < 32) { float m = 0.f;
#pragma unroll 8
            for (int r2 = 0; r2 < 64; ++r2) m = fmaxf(m, red[r2 * 32 + F.tid]);
            cm[half * 8192 + cc * 32 + F.tid] = m; }
    }
    __syncthreads();
    { float* cmu = wsp<float>(F, WS_CMAXU);
      for (int item = F.bid; item < 96 + 64 + 64; item += F.G) {
          const float* W; const float* gk; int K, N, cc, ob;
          if (item < 96) { W = F.w_uq; gk = F.q_norm_g; K = QLORA; N = NQF; cc = item; ob = 0; }
          else if (item < 160) { W = F.w_uk; gk = F.kv_norm_g; K = KVLORA; N = 2048; cc = item - 96; ob = NQF; }
          else { W = F.w_uv; gk = F.kv_norm_g; K = KVLORA; N = 2048; cc = item - 160; ob = NQF + 2048; }
          f32x4 mx = {0.f, 0.f, 0.f, 0.f};
          for (int r = rg; r < K; r += 64) { const f32x4 w = *(const f32x4*)(W + (size_t)r * N + cc * 32 + cg * 4); mx = __builtin_elementwise_max(mx, __builtin_elementwise_abs(w * gk[r])); }
          __syncthreads();
          *(LAS f32x4*)&red[rg * 32 + cg * 4] = mx;
          __syncthreads();
          if (F.tid < 32) { float m = 0.f;
#pragma unroll 8
              for (int r2 = 0; r2 < 64; ++r2) m = fmaxf(m, red[r2 * 32 + F.tid]);
              cmu[ob + cc * 32 + F.tid] = m; }
      }
      __syncthreads(); }
}
DEV void p1_win(const Frame& F) {
    LAS float* scr = (LAS float*)(F.lds + 32768 + F.wave * 8448);
    const float* cm = wsp<float>(F, WS_CMAXP); float* csb = wsp<float>(F, WS_CSB);
    unsigned char* wa = wsp<unsigned char>(F, WS_WIN); unsigned char* wb = wsp<unsigned char>(F, WS_WINB);
    const int gw = F.bid * 8 + F.wave, NGW = F.G * 8, lane = F.lane;
    constexpr int I_IN = (DM / 64) * (INW / 32);
#pragma unroll 1
    for (int item = gw; item < I_IN; item += NGW) {
        const int nblk = INW / 32, kb = item / nblk, nb = item % nblk, k0 = 64 * kb, n0 = 32 * nb;
        int dn; bool isB = false;
        if (n0 < C_KA) { isB = true; dn = B_QA + n0; } else if (n0 < C_VA) dn = A_KA + (n0 - C_KA); else if (n0 < C_QI) dn = A_VA + (n0 - C_VA); else if (n0 < C_KI) dn = A_QI + (n0 - C_QI);
        else if (n0 < C_WI) dn = A_KI + (n0 - C_KI); else if (n0 < C_CQ) dn = A_WI + (n0 - C_WI); else if (n0 < C_CKV) { isB = true; dn = B_CQ + (n0 - C_CQ); } else if (n0 < C_KR) dn = A_CKV + (n0 - C_CKV); else dn = A_KR + (n0 - C_KR);
#pragma unroll
        for (int i = 0; i < 32; ++i) { const int kk = 2 * i + (lane >> 5); scr[kk * 33 + (lane & 31)] = F.w_in[(size_t)(k0 + kk) * INW + n0 + (lane & 31)]; }
        LDS_WAIT(); asm volatile("" ::: "memory");
        if (kb == 0 && lane < 32) { const float m = fmaxf(cm[n0 + lane], cm[8192 + n0 + lane]); csb[(isB ? NA : 0) + dn + lane] = m * (1.f / 127.f); }
        const int c = lane & 7; unsigned char* WT = isB ? wb : wa;
#pragma unroll
        for (int j = 0; j < 4; ++j) { const int n = (lane >> 3) + 8 * j; const LAS float* sp = scr + (8 * c) * 33 + n;
            const float m = fmaxf(cm[n0 + n], cm[8192 + n0 + n]); const float inv = m > 0.f ? 127.f / m : 0.f;
            unsigned q[8];
#pragma unroll
            for (int e = 0; e < 8; ++e) { int v = (int)rintf(sp[e * 33] * inv); v = v > 127 ? 127 : (v < -127 ? -127 : v); q[e] = (unsigned)v & 0xffu; }
            u32x2 o; o.x = q[0] | (q[1] << 8) | (q[2] << 16) | (q[3] << 24); o.y = q[4] | (q[5] << 8) | (q[6] << 16) | (q[7] << 24);
            *(u32x2*)(WT + (size_t)(dn + n) * DM + k0 + 8 * c) = o; }
        LDS_WAIT(); asm volatile("" ::: "memory");
    }
    { const float* cmu = wsp<float>(F, WS_CMAXU); float* csu = wsp<float>(F, WS_CSU);
      constexpr int I_UQ = (QLORA / 64) * (NQF / 32), I_UK = (KVLORA / 64) * (2048 / 32);
#pragma unroll 1
      for (int it = gw; it < I_UQ + 2 * I_UK; it += NGW) {
          const float* W; const float* gk; int K, N, ob, r = it; unsigned char* WT;
          if (r < I_UQ) { W = F.w_uq; gk = F.q_norm_g; K = QLORA; N = NQF; ob = 0; WT = wsp<unsigned char>(F, WS_WUQ); }
          else if (r < I_UQ + I_UK) { r -= I_UQ; W = F.w_uk; gk = F.kv_norm_g; K = KVLORA; N = 2048; ob = NQF; WT = wsp<unsigned char>(F, WS_WUKV); }
          else { r -= I_UQ + I_UK; W = F.w_uv; gk = F.kv_norm_g; K = KVLORA; N = 2048; ob = NQF + 2048; WT = wsp<unsigned char>(F, WS_WUKV) + (size_t)2048 * KVLORA; }
          const int nblk = N / 32, kb = r / nblk, nb = r % nblk, k0 = 64 * kb, n0 = 32 * nb;
#pragma unroll
          for (int i = 0; i < 32; ++i) { const int kk = 2 * i + (lane >> 5); scr[kk * 33 + (lane & 31)] = W[(size_t)(k0 + kk) * N + n0 + (lane & 31)] * gk[k0 + kk]; }
          LDS_WAIT(); asm volatile("" ::: "memory");
          if (kb == 0 && lane < 32) csu[ob + n0 + lane] = cmu[ob + n0 + lane] * (1.f / 127.f);
          const int c = lane & 7;
#pragma unroll
          for (int j = 0; j < 4; ++j) { const int n = (lane >> 3) + 8 * j; const LAS float* sp = scr + (8 * c) * 33 + n;
              const float m = cmu[ob + n0 + n]; const float inv = m > 0.f ? 127.f / m : 0.f;
              unsigned q[8];
#pragma unroll
              for (int e = 0; e < 8; ++e) { int v = (int)rintf(sp[e * 33] * inv); v = v > 127 ? 127 : (v < -127 ? -127 : v); q[e] = (unsigned)v & 0xffu; }
              u32x2 o; o.x = q[0] | (q[1] << 8) | (q[2] << 16) | (q[3] << 24); o.y = q[4] | (q[5] << 8) | (q[6] << 16) | (q[7] << 24);
              *(u32x2*)(WT + (size_t)(n0 + n) * K + k0 + 8 * c) = o; }
          LDS_WAIT(); asm volatile("" ::: "memory");
      } }
    { u32x4* z = (u32x4*)(wa + (size_t)A_END * DM); const int n16 = (NA - A_END) * DM / 16;
      for (int i = F.bid * 512 + F.tid; i < n16; i += F.G * 512) z[i] = (u32x4){0u, 0u, 0u, 0u};
      if (F.bid == 0 && F.tid < NA - A_END) csb[A_END + F.tid] = 0.f; }
}
DEV void wt_desc(const Frame& F, int it, const float*& src, unsigned char*& dst, int& N, int& K, float& scale) {
    constexpr int I_UP = (DM / 64) * (DFF / 256), I_DN = (DFF / 64) * (DM / 256);
    const float* W; unsigned char* WT; int r = it;
    if (r < I_UP) { W = F.w_up; WT = wsp<unsigned char>(F, WS_WUP); K = DM; N = DFF; scale = 128.f; }
    else if (r < I_UP + I_DN) { r -= I_UP; W = F.w_dn; WT = wsp<unsigned char>(F, WS_WDN); K = DFF; N = DM; scale = 256.f; }
    else { r -= I_UP + I_DN; W = F.w_o; WT = wsp<unsigned char>(F, WS_WO); K = DM; N = DM; scale = 0.f; }
    const int nblk = N / 256, kb = r / nblk, nb = r % nblk;
    if (scale == 0.f) scale = (64 * kb < 2048) ? 128.f : 8.f;
    src = W + (size_t)(64 * kb) * N + 256 * nb; dst = WT + (size_t)(256 * nb) * K + 64 * kb;
}
DEV void p0_weights(const Frame& F) {
    constexpr int TS = 64 * 257;
    constexpr int NITEMS = (DM / 64) * (DFF / 256) + (DFF / 64) * (DM / 256) + (DM / 64) * (DM / 256);
    LAS float* buf = (LAS float*)F.lds;
    const int tid = F.tid, lane = F.lane, wave = F.wave;
    f32x4 r[8];
    const float* src; unsigned char* dst; int N, K; float scale;
#define WT_LOAD() do { const float* p_ = src + (size_t)(8 * wave) * N + 4 * lane; _Pragma("unroll") for (int i = 0; i < 8; ++i) r[i] = *(const f32x4*)(p_ + (size_t)i * N); } while (0)
#define WT_WRITE(sel) do { LAS float* T_ = buf + (sel) * TS + (8 * wave) * 257 + 4 * lane; _Pragma("unroll") for (int i = 0; i < 8; ++i) { T_[i * 257] = r[i].x; T_[i * 257 + 1] = r[i].y; T_[i * 257 + 2] = r[i].z; T_[i * 257 + 3] = r[i].w; } } while (0)
    int it = F.bid;
    __syncthreads();
    if (it < NITEMS) { wt_desc(F, it, src, dst, N, K, scale); WT_LOAD(); WT_WRITE(0); }
    __syncthreads();
    int sel = 0;
#pragma unroll 1
    for (; it < NITEMS; it += F.G) {
        unsigned char* cdst = dst; const int cK = K; const float cscale = scale;
        const bool more = (it + F.G < NITEMS);
        if (more) { wt_desc(F, it + F.G, src, dst, N, K, scale); WT_LOAD(); }
        { const LAS float* T = buf + sel * TS; const int c = tid & 7;
#pragma unroll
          for (int j = 0; j < 4; ++j) { const int n = (tid >> 3) + 64 * j; const LAS float* sp = T + (8 * c) * 257 + n;
              u32x2 o; o.x = pg8::pk4_fp8(sp[0 * 257] * cscale, sp[1 * 257] * cscale, sp[2 * 257] * cscale, sp[3 * 257] * cscale);
              o.y = pg8::pk4_fp8(sp[4 * 257] * cscale, sp[5 * 257] * cscale, sp[6 * 257] * cscale, sp[7 * 257] * cscale);
              *(u32x2*)(cdst + (size_t)n * cK + 8 * c) = o; } }
        if (more) WT_WRITE(sel ^ 1);
        __syncthreads();
        sel ^= 1;
    }
#undef WT_LOAD
#undef WT_WRITE
    { float* ct = wsp<float>(F, WS_COS); float* st = wsp<float>(F, WS_SIN);
      for (int i = F.bid * 512 + F.tid; i < M * 32; i += F.G * 512) { const int row = i >> 5, f = i & 31;
          const double inv = exp2(-(double)(2 * f) / 64.0 * 13.287712379549449);
          const double ang = (double)F.pos[row] * inv;
          ct[i] = (float)cos(ang); st[i] = (float)sin(ang); } }
}

DEV float modv(const Frame& F, const float* modp, int k, int b, int col) {
    return F.b_ada[k * DM + col] + modp[(size_t)(0 * 4 + b) * (6 * DM) + k * DM + col] + modp[(size_t)(1 * 4 + b) * (6 * DM) + k * DM + col];
}
template <int OUT_FP8, bool SRC_BF16>
DEV void p_adaln(const Frame& F, const void* src, const float* gain, int kshift, int kscale, bool write_gates) {
    LAS float* Al = (LAS float*)F.lds; LAS float* Bl = Al + DM;
    const float* modp = wsp<float>(F, WS_MODP); bf16* H = wsp<bf16>(F, WS_H);
    for (int rb = F.bid; rb < M / 64; rb += F.G) {
        const int b = (rb * 64) / SEQ;
        const int row0 = rb * 64 + F.wave * 8;
        f32x4 va[16], vb[16];
#define AD_LOAD(V, r) do { if (SRC_BF16) { const u32x2* xb_ = (const u32x2*)((const bf16*)src + (size_t)(r) * DM) + F.lane; _Pragma("unroll") for (int j = 0; j < 16; ++j) { const u32x2 w_ = xb_[64 * j]; V[j] = (f32x4){bflo(w_.x), bfhi(w_.x), bflo(w_.y), bfhi(w_.y)}; } } \
        else { const f32x4* xr_ = (const f32x4*)((const float*)src + (size_t)(r) * DM) + F.lane; _Pragma("unroll") for (int j = 0; j < 16; ++j) V[j] = xr_[64 * j]; } } while (0)
#define AD_PROC(V, r) do { float s_ = 0.f; _Pragma("unroll") for (int j = 0; j < 16; ++j) s_ += (V[j].x * V[j].x + V[j].y * V[j].y) + (V[j].z * V[j].z + V[j].w * V[j].w); \
            const float rstd_ = 1.f / sqrtf(wave_sum(s_) * (1.f / DM) + EPS); \
            u32x2* o8_ = (u32x2*)(H + (size_t)(r) * DM) + F.lane; unsigned* o4_ = (unsigned*)((unsigned char*)H + (size_t)(r) * DM) + F.lane; unsigned* q4_ = (unsigned*)(wsp<unsigned char>(F, WS_H8) + (size_t)(r) * DM) + F.lane; \
            const unsigned lo_ = opq(4u * (unsigned)F.lane); \
            if (OUT_FP8 == 3) {   float ym_ = 0.f; \
                _Pragma("unroll") for (int j = 0; j < 16; ++j) { const f32x4 a_ = *(const LAS f32x4*)&Al[lo_ + 256 * j], b_ = *(const LAS f32x4*)&Bl[lo_ + 256 * j]; \
                    const f32x4 y_ = V[j] * rstd_ * a_ + b_; V[j] = y_; ym_ = fmaxf(fmaxf(ym_, fmaxf(fabsf(y_.x), fabsf(y_.y))), fmaxf(fabsf(y_.z), fabsf(y_.w))); } \
                _Pragma("unroll") for (int o = 1; o < 64; o <<= 1) ym_ = fmaxf(ym_, __shfl_xor(ym_, o)); \
                const float inv_ = ym_ > 0.f ? 127.f / ym_ : 0.f; if (F.lane == 0) wsp<float>(F, WS_RSA)[r] = ym_ * (1.f / 127.f); \
                _Pragma("unroll") for (int j = 0; j < 16; ++j) { const f32x4 q_ = V[j] * inv_; \
                    o4_[64 * j] = ((unsigned)(int)rintf(q_.x) & 0xffu) | (((unsigned)(int)rintf(q_.y) & 0xffu) << 8) | (((unsigned)(int)rintf(q_.z) & 0xffu) << 16) | (((unsigned)(int)rintf(q_.w) & 0xffu) << 24); } } \
            else _Pragma("unroll") for (int j = 0; j < 16; ++j) { const f32x4 a_ = *(const LAS f32x4*)&Al[lo_ + 256 * j], b_ = *(const LAS f32x4*)&Bl[lo_ + 256 * j]; \
                const f32x4 y_ = V[j] * rstd_ * a_ + b_; \
                if (OUT_FP8 == 1) { o4_[64 * j] = pg8::pk4_fp8(fminf(fmaxf(y_.x, -448.f), 448.f), fminf(fmaxf(y_.y, -448.f), 448.f), fminf(fmaxf(y_.z, -448.f), 448.f), fminf(fmaxf(y_.w, -448.f), 448.f)); } \
                else { u32x2 w_; w_.x = pk2(y_.x, y_.y); w_.y = pk2(y_.z, y_.w); o8_[64 * j] = w_; \
                    if (OUT_FP8 == 2) q4_[64 * j] = pg8::pk4_fp8(fminf(fmaxf(y_.x, -448.f), 448.f), fminf(fmaxf(y_.y, -448.f), 448.f), fminf(fmaxf(y_.z, -448.f), 448.f), fminf(fmaxf(y_.w, -448.f), 448.f)); } } } while (0)
        AD_LOAD(va, row0);
        __syncthreads();
        for (int col = F.tid; col < DM; col += 512) { Al[col] = gain[col] * (1.f + modv(F, modp, kscale, b, col)); Bl[col] = modv(F, modp, kshift, b, col); }
        if (write_gates && (rb % (SEQ / 64)) == 0) { float* g = wsp<float>(F, WS_GATE);
            for (int col = F.tid; col < DM; col += 512) { g[b * DM + col] = modv(F, modp, 2, b, col); g[NB * DM + b * DM + col] = modv(F, modp, 5, b, col); } }
        __syncthreads();
#pragma unroll 1
        for (int i = 0; i < 8; i += 2) {
            AD_LOAD(vb, row0 + i + 1);
            AD_PROC(va, row0 + i);
            if (i + 2 < 8) AD_LOAD(va, row0 + i + 2);
            AD_PROC(vb, row0 + i + 1);
        }
#undef AD_LOAD
#undef AD_PROC
    }
}
DEV void p_final(const Frame& F) {
    const int gw = F.bid * 8 + F.wave, NGW = F.G * 8;
    f32x4 va[16], vb[16];
#define FN_LOAD(V, r) do { const u32x2* xb_ = (const u32x2*)(wsp<bf16>(F, WS_X2) + (size_t)(r) * DM) + F.lane; _Pragma("unroll") for (int j = 0; j < 16; ++j) { const u32x2 w_ = xb_[64 * j]; V[j] = (f32x4){bflo(w_.x), bfhi(w_.x), bflo(w_.y), bfhi(w_.y)}; } } while (0)
#define FN_PROC(V, r) do { float s_ = 0.f; _Pragma("unroll") for (int j = 0; j < 16; ++j) s_ += (V[j].x * V[j].x + V[j].y * V[j].y) + (V[j].z * V[j].z + V[j].w * V[j].w); \
        const float rstd_ = 1.f / sqrtf(wave_sum(s_) * (1.f / DM) + EPS); f32x4* xw_ = (f32x4*)(F.out + (size_t)(r) * DM) + F.lane; \
        _Pragma("unroll") for (int j = 0; j < 16; ++j) { const f32x4 g_ = *((const f32x4*)F.final_g + F.lane + 64 * j); xw_[64 * j] = V[j] * rstd_ * g_; } } while (0)
    int row = gw;
    if (row < M) FN_LOAD(va, row);
#pragma unroll 1
    for (; row < M; row += 2 * NGW) {
        const int r1 = row + NGW, r2 = row + 2 * NGW;
        if (r1 < M) FN_LOAD(vb, r1);
        FN_PROC(va, row);
        if (r2 < M) FN_LOAD(va, r2);
        if (r1 < M) FN_PROC(vb, r1);
    }
#undef FN_LOAD
#undef FN_PROC
}
DEV void p2_rowstats(const Frame& F) {
    const int gw = F.bid * 8 + F.wave, NGW = F.G * 8;
    const bf16* pa = wsp<bf16>(F, WS_PA); const bf16* pb = wsp<bf16>(F, WS_PB);
    float* rsq = wsp<float>(F, WS_RSQ); float* rskv = wsp<float>(F, WS_RSKV); int* ck = wsp<int>(F, WS_CK); int* tmm = wsp<int>(F, WS_TMM);
    const float* ct = wsp<float>(F, WS_COS); const float* st = wsp<float>(F, WS_SIN); bf16* kro = wsp<bf16>(F, WS_KROPE);
#pragma unroll 1
    for (int row0 = gw; row0 < M; row0 += 4 * NGW) {
        u32x4 a0[4], a1[4], c0[4]; float x1[4], x2[4], cs[4], sn[4]; int ps[4];
#pragma unroll
        for (int q = 0; q < 4; ++q) { const int row = row0 + q * NGW; const bf16* pr = pa + (size_t)row * NA; const bf16* pq = pb + (size_t)row * NBQ;
            a0[q] = *((const u32x4*)(pq + B_CQ) + F.lane); a1[q] = *((const u32x4*)(pq + B_CQ) + 64 + F.lane); c0[q] = *((const u32x4*)(pr + A_CKV) + F.lane);
            x1[q] = bf2f(pr[A_KR + (F.lane & 31)]); x2[q] = bf2f(pr[A_KR + 32 + (F.lane & 31)]); cs[q] = ct[row * 32 + (F.lane & 31)]; sn[q] = st[row * 32 + (F.lane & 31)]; ps[q] = F.pos[row]; }
#pragma unroll
        for (int q = 0; q < 4; ++q) { const int row = row0 + q * NGW; float sq = 0.f, sk = 0.f;
#pragma unroll
            for (int j = 0; j < 4; ++j) { float l0 = bflo(a0[q][j]), h0 = bfhi(a0[q][j]), l1 = bflo(a1[q][j]), h1 = bfhi(a1[q][j]), l2 = bflo(c0[q][j]), h2 = bfhi(c0[q][j]);
                sq += l0 * l0 + h0 * h0 + l1 * l1 + h1 * h1; sk += l2 * l2 + h2 * h2; }
            sq = wave_sum(sq); sk = wave_sum(sk);
            float mq = 0.f, mk = 0.f;
#pragma unroll
            for (int j = 0; j < 4; ++j) { mq = fmaxf(mq, fmaxf(fmaxf(fabsf(bflo(a0[q][j])), fabsf(bfhi(a0[q][j]))), fmaxf(fabsf(bflo(a1[q][j])), fabsf(bfhi(a1[q][j]))))); mk = fmaxf(mk, fmaxf(fabsf(bflo(c0[q][j])), fabsf(bfhi(c0[q][j])))); }
#pragma unroll
            for (int o = 1; o < 64; o <<= 1) { mq = fmaxf(mq, __shfl_xor(mq, o)); mk = fmaxf(mk, __shfl_xor(mk, o)); }
            const float iq = mq > 0.f ? 127.f / mq : 0.f, ik = mk > 0.f ? 127.f / mk : 0.f;
            if (F.lane == 0) { rsq[row] = mq * (1.f / 127.f) / sqrtf(sq * (1.f / QLORA) + EPS); rskv[row] = mk * (1.f / 127.f) / sqrtf(sk * (1.f / KVLORA) + EPS); ck[row] = floordiv64(ps[q]); }
            { auto q8 = [](unsigned w, float inv) -> unsigned { return ((unsigned)(int)rintf(bflo(w) * inv) & 0xffu) | (((unsigned)(int)rintf(bfhi(w) * inv) & 0xffu) << 8); };
              u32x2 w0, w1, w2;
              w0.x = q8(a0[q][0], iq) | (q8(a0[q][1], iq) << 16); w0.y = q8(a0[q][2], iq) | (q8(a0[q][3], iq) << 16);
              w1.x = q8(a1[q][0], iq) | (q8(a1[q][1], iq) << 16); w1.y = q8(a1[q][2], iq) | (q8(a1[q][3], iq) << 16);
              w2.x = q8(c0[q][0], ik) | (q8(c0[q][1], ik) << 16); w2.y = q8(c0[q][2], ik) | (q8(c0[q][3], ik) << 16);
              unsigned char* cq8 = wsp<unsigned char>(F, WS_CQ8) + (size_t)row * QLORA; unsigned char* ck8 = wsp<unsigned char>(F, WS_CKV8) + (size_t)row * KVLORA;
              *((u32x2*)cq8 + F.lane) = w0; *((u32x2*)(cq8 + 512) + F.lane) = w1; *((u32x2*)ck8 + F.lane) = w2; }
            if (F.lane < 32) { const float r1_ = x1[q] * cs[q] - x2[q] * sn[q], r2_ = x1[q] * sn[q] + x2[q] * cs[q]; kro[(size_t)row * 64 + F.lane] = (bf16)f2bf(r1_); kro[(size_t)row * 64 + 32 + F.lane] = (bf16)f2bf(r2_);
                unsigned char* kro8 = wsp<unsigned char>(F, WS_KROPE8); const unsigned w8_ = __builtin_amdgcn_cvt_pk_fp8_f32(r1_, r2_, 0u, false); kro8[(size_t)row * 64 + F.lane] = (unsigned char)(w8_ & 0xffu); kro8[(size_t)row * 64 + 32 + F.lane] = (unsigned char)((w8_ >> 8) & 0xffu); } }
    }
    for (int tile = gw; tile < M / 64; tile += NGW) { const int c = floordiv64(F.pos[tile * 64 + F.lane]); const int mn = wave_min_i(c), mx = wave_max_i(c);
        if (F.lane == 0) { tmm[tile] = mn; tmm[256 + tile] = mx; } }
}

typedef __bf16 bf16x2_t __attribute__((ext_vector_type(2)));
typedef short v4i16_t __attribute__((ext_vector_type(4)));
DEV unsigned cvtpk(float lo, float hi) { f32x2 v = {lo, hi}; bf16x2_t b = __builtin_convertvector(v, bf16x2_t); return __builtin_bit_cast(unsigned, b); }
DEV int crow(int r, int hi) { return (r & 3) + 8 * (r >> 2) + 4 * hi; }
#define KSWZ(row, colB) ((row) * 256 + ((colB) ^ (((row) & 15) << 4)))
DEV unsigned mbcnt64(unsigned long long m) { return __builtin_amdgcn_mbcnt_hi((unsigned)(m >> 32), __builtin_amdgcn_mbcnt_lo((unsigned)m, 0u)); }

typedef _Float16 h16x2 __attribute__((ext_vector_type(2)));
DEV float fma_mix_lo(float a, unsigned w, float c) { float d; asm("v_fma_mix_f32 %0, %1, %2, %3 op_sel:[0,0,0] op_sel_hi:[0,1,0]" : "=v"(d) : "v"(a), "v"(w), "v"(c)); return d; }
DEV float fma_mix_hi(float a, unsigned w, float c) { float d; asm("v_fma_mix_f32 %0, %1, %2, %3 op_sel:[0,1,0] op_sel_hi:[0,1,0]" : "=v"(d) : "v"(a), "v"(w), "v"(c)); return d; }
template <int VAR>
DEV void idx_phase(const Frame& F) {
    const bf16* proj = wsp<bf16>(F, WS_PA); float* sc = VAR ? wsp<float>(F, WS_MIX) : wsp<float>(F, WS_SC); const int* ck = wsp<int>(F, WS_CK); const int* tmm = wsp<int>(F, WS_TMM);
    LAS unsigned char* kl = F.lds;
    const int r32 = F.lane & 31, hi = F.lane >> 5;
    const int srow = F.tid >> 2, sch = (F.tid & 3) * 4;
    for (int p = F.bid; p < 512; p += F.G) {
#pragma unroll 1
        for (int side = 0; side < 2; ++side) {
            const int b = p >> 7, q = p & 127, g = side ? 255 - q : q;
            const int t0 = b * SEQ + 16 * g;
            const int cqmax = wave_max_i(ck[t0 + (F.lane & 15)]);
            const unsigned long long mask = __ballot(tmm[b * 64 + F.lane] <= cqmax);
            unsigned long long m2 = (mask | (mask >> 1)) & 0x5555555555555555ull;
            const int n = __popcll(m2);
            if (n == 0) continue;
            bf16x8 aq[2][8]; unsigned wq[16];
            { const bf16* qp0 = proj + (size_t)(t0 + 2 * F.wave) * NA; const bf16* qp1 = qp0 + NA;
#pragma unroll
              for (int s = 0; s < 8; ++s) { aq[0][s] = *(const bf16x8*)(qp0 + A_QI + r32 * 128 + 16 * s + 8 * hi); aq[1][s] = *(const bf16x8*)(qp1 + A_QI + r32 * 128 + 16 * s + 8 * hi); }
#pragma unroll
              for (int r = 0; r < 16; ++r) wq[r] = __builtin_bit_cast(unsigned, (h16x2){(_Float16)bf2f(qp0[A_WI + crow(r, hi)]), (_Float16)bf2f(qp1[A_WI + crow(r, hi)])}); }
            bf16x8 st[4];
#define IDX_LOAD(j2) do { const bf16* kp = proj + (size_t)(b * SEQ + 128 * (j2) + srow) * NA + A_KI + sch * 8; _Pragma("unroll") for (int c = 0; c < 4; ++c) st[c] = *(const bf16x8*)(kp + 8 * c); } while (0)
#define IDX_WRITE(buf) do { _Pragma("unroll") for (int c = 0; c < 4; ++c) *(LAS bf16x8*)(kl + (buf) * 32768 + KSWZ(srow, (sch + c) * 16)) = st[c]; } while (0)
#define IDX_LDB(BK, kb) do { _Pragma("unroll") for (int s = 0; s < 8; ++s) BK[s] = *(const LAS bf16x8*)(Ks + KSWZ(32 * (kb) + r32, (16 * s + 8 * hi) * 2)); } while (0)
#define IDX_MMA(ACC, q, BK) do { ACC = (f32x16){}; _Pragma("unroll") for (int s = 0; s < 8; ++s) ACC = __builtin_amdgcn_mfma_f32_32x32x16_bf16(aq[q][s], BK[s], ACC, 0, 0, 0); } while (0)
#define IDX_EPI(P, ACC, q) do { P = 0.f; _Pragma("unroll") for (int r = 0; r < 16; ++r) P = (q) ? fma_mix_hi(fmaxf(ACC[r], 0.f), wq[r], P) : fma_mix_lo(fmaxf(ACC[r], 0.f), wq[r], P); } while (0)
#define IDX_OUT(kb) do { auto rr = __builtin_amdgcn_permlane32_swap(__float_as_uint(p0), __float_as_uint(p1), false, false); \
        sc[(size_t)(t0 + 2 * F.wave + hi) * SEQ + 128 * j + 32 * (kb) + r32] = __uint_as_float(rr[0]) + __uint_as_float(rr[1]); } while (0)
            int j = __builtin_ctzll(m2) >> 1; m2 &= m2 - 1;
            __syncthreads();
            IDX_LOAD(j); IDX_WRITE(0); __syncthreads();
#pragma unroll 1
            for (int i = 0; i < n; ++i) {
                const bool more = (i + 1 < n);
                int jn = j; if (more) { jn = __builtin_ctzll(m2) >> 1; m2 &= m2 - 1; IDX_LOAD(jn); }
                const LAS unsigned char* Ks = kl + (i & 1) * 32768;
                bf16x8 bkA[8], bkB[8]; f32x16 acc0, acc1; float p0, p1;
                IDX_LDB(bkA, 0); SBAR(); IDX_LDB(bkB, 1); SBAR();
                IDX_MMA(acc0, 0, bkA); SBAR();
                IDX_MMA(acc1, 1, bkA); IDX_EPI(p0, acc0, 0); SBAR();
                IDX_LDB(bkA, 2); SBAR();
                IDX_MMA(acc0, 0, bkB); IDX_EPI(p1, acc1, 1); IDX_OUT(0); SBAR();
                IDX_MMA(acc1, 1, bkB); IDX_EPI(p0, acc0, 0); SBAR();
                IDX_LDB(bkB, 3); SBAR();
                IDX_MMA(acc0, 0, bkA); IDX_EPI(p1, acc1, 1); IDX_OUT(1); SBAR();
                IDX_MMA(acc1, 1, bkA); IDX_EPI(p0, acc0, 0); SBAR();
                IDX_MMA(acc0, 0, bkB); IDX_EPI(p1, acc1, 1); IDX_OUT(2); SBAR();
                IDX_MMA(acc1, 1, bkB); IDX_EPI(p0, acc0, 0); SBAR();
                IDX_EPI(p1, acc1, 1); IDX_OUT(3);
                if (more) IDX_WRITE((i + 1) & 1);
                __syncthreads();
                j = jn;
            }
#undef IDX_LOAD
#undef IDX_WRITE
#undef IDX_LDB
#undef IDX_MMA
#undef IDX_EPI
#undef IDX_OUT
        }
    }
}

DEV unsigned f2ord(float f) { const unsigned u = __float_as_uint(f); return (u & 0x80000000u) ? ~u : (u | 0x80000000u); }
#if defined(DBG) && DBG
#define TOPK_GLOBAL 1
#else
#define TOPK_GLOBAL 0
#endif
template <int NS, bool TOLDS = false>
DEV int topk_row(const Frame& F, int t, int b, int cq, unsigned long long vis, unsigned long long part, LAS int* idxl = nullptr) {
    const float* sc = wsp<float>(F, WS_SC); const int* ck = wsp<int>(F, WS_CK); int* idx = wsp<int>(F, WS_IDX); int* cnt = wsp<int>(F, WS_CNT);
    unsigned u[NS]; int nadm = 0;
    constexpr bool KEEPG = !TOLDS || TOPK_GLOBAL;
    const float* srow = sc + (size_t)t * SEQ; const unsigned l4 = opq(4u * (unsigned)F.lane);
#pragma unroll
    for (int j = 0; j < NS; ++j) { float s = 0.f; if ((vis >> j) & 1ull) s = ldg<float>(srow + 64 * j, l4); u[j] = __float_as_uint(s); }
#pragma unroll
    for (int j = 0; j < NS; ++j) { unsigned v = 0u; if ((vis >> j) & 1ull) { v = f2ord(__uint_as_float(u[j])); v = v ? v : 1u; } u[j] = v; }
    if (part) {
#pragma unroll
        for (int j = 0; j < NS; ++j) if ((part >> j) & 1ull) { if (ck[b * SEQ + 64 * j + F.lane] > cq) u[j] = 0u; }
    }
#pragma unroll
    for (int j = 0; j < NS; ++j) nadm += __popcll(__ballot(u[j] != 0u));
    unsigned T = 0u; int need_eq = 0;
    if (nadm > TOPK) {
        unsigned umax = 0u;
#pragma unroll
        for (int j = 0; j < NS; ++j) umax = u[j] > umax ? u[j] : umax;
#pragma unroll
        for (int o = 1; o < 64; o <<= 1) { const unsigned v = (unsigned)__shfl_xor((int)umax, o); umax = v > umax ? v : umax; }
        umax = __builtin_amdgcn_readfirstlane(umax);
#pragma unroll 1
        for (int bit = 31; bit >= 0; --bit) { const unsigned cand = T | (1u << bit); if (cand > umax) continue; int c = 0;
#pragma unroll
            for (int j = 0; j < NS; ++j) c += __popcll(__ballot(u[j] >= cand));
            if (c >= TOPK) { T = cand; if (c == TOPK) break; } }
        int cgt = 0;
#pragma unroll
        for (int j = 0; j < NS; ++j) cgt += __popcll(__ballot(u[j] > T));
        need_eq = TOPK - cgt;
    }
    int base = 0, eqbase = 0; int* orow = idx + (size_t)t * TOPK; const int lnk = (int)opq((unsigned)F.lane);
#pragma unroll
    for (int j = 0; j < NS; ++j) { const bool gt = u[j] > T, eq = (u[j] == T);
        const unsigned long long meq = __ballot(eq); const bool take = gt || (eq && (int)(eqbase + mbcnt64(meq)) < need_eq);
        const unsigned long long mt = __ballot(take); if (take) { const int p_ = base + (int)mbcnt64(mt); if (KEEPG) orow[p_] = 64 * j + lnk; if (TOLDS) idxl[p_] = 64 * j + lnk; }
        base += __popcll(mt); eqbase += __popcll(meq); }
    if (KEEPG && F.lane == 0) cnt[t] = base;
    return base;
}
DEV void topk_phase(const Frame& F) {
    const int* ck = wsp<int>(F, WS_CK); const int* tmm = wsp<int>(F, WS_TMM);
    const int gw = F.bid * 8 + F.wave, NGW = F.G * 8;
#pragma unroll 1
    for (int t = gw; t < M; t += NGW) {
        const int b = t / SEQ; const int cq = __builtin_amdgcn_readfirstlane(ck[t]);
        const int tmn = tmm[b * 64 + F.lane], tmx = tmm[256 + b * 64 + F.lane];
        const unsigned long long vis = __ballot(tmn <= cq), part = __ballot(tmn <= cq && tmx > cq);
        if ((vis >> 16) == 0ull) topk_row<16>(F, t, b, cq, vis, part);
        else if ((vis >> 32) == 0ull) topk_row<32>(F, t, b, cq, vis, part);
        else if ((vis >> 48) == 0ull) topk_row<48>(F, t, b, cq, vis, part);
        else topk_row<64>(F, t, b, cq, vis, part);
    }
}

DEV long sp_bf8_fp8(bf16x8 v) { const u32x4 w = __builtin_bit_cast(u32x4, v);
    u32x2 r; r.x = pg8::pk4_fp8(__uint_as_float(w.x << 16), __uint_as_float(w.x & 0xffff0000u), __uint_as_float(w.y << 16), __uint_as_float(w.y & 0xffff0000u));
    r.y = pg8::pk4_fp8(__uint_as_float(w.z << 16), __uint_as_float(w.z & 0xffff0000u), __uint_as_float(w.w << 16), __uint_as_float(w.w & 0xffff0000u)); return __builtin_bit_cast(long, r); }
DEV bf16x8 sp_fp8_bf8(u32x2 w) {
    const f32x2 a = __builtin_amdgcn_cvt_pk_f32_fp8((int)w.x, false), b = __builtin_amdgcn_cvt_pk_f32_fp8((int)w.x, true), c = __builtin_amdgcn_cvt_pk_f32_fp8((int)w.y, false), d = __builtin_amdgcn_cvt_pk_f32_fp8((int)w.y, true);
    const u32x4 o = {cvtpk(a.x, a.y), cvtpk(b.x, b.y), cvtpk(c.x, c.y), cvtpk(d.x, d.y)}; return __builtin_bit_cast(bf16x8, o); }
DEV unsigned offb(unsigned row, unsigned ch) { return 256u * row + 16u * (ch ^ (((row & 3u) << 2) | ((row >> 2) & 3u))); }
DEV s16x4 vtr(const LAS unsigned char* p) { return __builtin_bit_cast(s16x4, __builtin_amdgcn_ds_read_tr16_b64_v4i16((LAS v4i16_t*)p)); }
template <bool FUSED>
DEV void sparse_phase(const Frame& F) {
    const bf16* proj = wsp<bf16>(F, WS_PA); const bf16* projb = wsp<bf16>(F, WS_PB); const int* idxg = wsp<int>(F, WS_IDX); const int* cntg = wsp<int>(F, WS_CNT); unsigned char* mix = wsp<unsigned char>(F, WS_MIX);
    LAS unsigned char* wl = F.lds + F.wave * 10240;
    LAS int* idxl = (LAS int*)wl; LAS float* distl = (LAS float*)(wl + 1024); LAS unsigned char* vimg = wl + 2048;
    const float LOG2E = 1.4426950408889634f;
    const float qscale = 0.088388347648318440f * LOG2E;
    const bool xmap = (F.G == 256);
    const int xcd = F.bid & 7, wi = ((F.bid >> 3) << 1) | (xcd & 1);
    const int tbase = xmap ? (xcd >> 1) * SEQ + wi * 64 + F.wave * 8 : F.bid * 8 + F.wave, tstep = xmap ? 1 : F.G * 8, tcount = xmap ? 8 : (M - tbase + F.G * 8 - 1) / (F.G * 8);
    i32x4 nid = {0, 0, 0, 0}, nps = {0, 0, 0, 0}; int nn = 0, npt = 0;
    if (!FUSED && tcount > 0) { const int t0 = tbase; nid = *(const i32x4*)(idxg + (size_t)t0 * TOPK + 4 * F.lane); nn = cntg[t0]; npt = F.pos[t0];
#pragma unroll
        for (int c = 0; c < 4; ++c) { const bool ok = (4 * F.lane + c) < nn; const int ii = ok ? nid[c] : 0; nid[c] = ii; nps[c] = F.pos[(t0 / SEQ) * SEQ + ii]; } }
#pragma unroll 1
    for (int qi = 0; qi < tcount; ++qi) {
        const int t = (FUSED && xmap) ? (xcd >> 1) * SEQ + ((((qi >> 2) ^ (F.wave >> 2)) & 1) ? 127 - wi : wi) * 32 + F.wave * 4 + (qi & 3) : tbase + qi * tstep;
        const int b = t / SEQ; int n = nn; int pt = npt;
        if (FUSED) {
            const int* ck = wsp<int>(F, WS_CK); const int* tmm = wsp<int>(F, WS_TMM);
            const int cq = __builtin_amdgcn_readfirstlane(ck[t]); pt = F.pos[t];
            const int tmn = tmm[b * 64 + F.lane], tmx = tmm[256 + b * 64 + F.lane];
            const unsigned long long vis = __ballot(tmn <= cq), part = __ballot(tmn <= cq && tmx > cq);
            if ((vis >> 16) == 0ull) n = topk_row<16, true>(F, t, b, cq, vis, part, idxl);
            else if ((vis >> 32) == 0ull) n = topk_row<32, true>(F, t, b, cq, vis, part, idxl);
            else if ((vis >> 48) == 0ull) n = topk_row<48, true>(F, t, b, cq, vis, part, idxl);
            else n = topk_row<64, true>(F, t, b, cq, vis, part, idxl);
            i32x4 idv = *(const LAS i32x4*)(idxl + 4 * F.lane); f32x4 ds;
#pragma unroll
            for (int c = 0; c < 4; ++c) { const bool ok = (4 * F.lane + c) < n; const int ii = ok ? idv[c] : 0; idv[c] = ii; const int ps = F.pos[b * SEQ + ii]; ds[c] = ok ? fabsf((float)(pt - ps)) : __builtin_inff(); }
            *(LAS i32x4*)(idxl + 4 * F.lane) = idv; *(LAS f32x4*)(distl + 4 * F.lane) = ds;
        } else { f32x4 ds;
#pragma unroll
          for (int c = 0; c < 4; ++c) ds[c] = ((4 * F.lane + c) < n) ? fabsf((float)(pt - nps[c])) : __builtin_inff();
          *(LAS i32x4*)(idxl + 4 * F.lane) = nid; *(LAS f32x4*)(distl + 4 * F.lane) = ds; }
        const int lz_ = (int)opq((unsigned)F.lane); const int l15 = lz_ & 15, g = lz_ >> 4, q4 = l15 >> 2, p4 = l15 & 3;
        const float slope2 = exp2f(-0.5f * (float)(l15 + 1)) * LOG2E;
        const int tn = t + tstep; const bool has_next = !FUSED && (qi + 1 < tcount);
        if (has_next) { nid = *(const i32x4*)(idxg + (size_t)tn * TOPK + 4 * F.lane); nn = cntg[tn]; npt = F.pos[tn]; }
        const unsigned char* pk_ = wsp<unsigned char>(F, WS_KAV8) + (size_t)(b * SEQ) * 256;
        long qf[2][2];
#pragma unroll
        for (int kk = 0; kk < 2; ++kk)
#pragma unroll
            for (int t2 = 0; t2 < 2; ++t2) qf[kk][t2] = sp_bf8_fp8(*(const bf16x8*)(projb + (size_t)t * NBQ + B_QA + l15 * 128 + 64 * kk + 16 * g + 8 * t2));
        f32x4 s[16];
        u32x4 kf[2][4][2];
#define SP_LOADK(buf, j4) do { _Pragma("unroll") for (int jj = 0; jj < 4; ++jj) { const unsigned ko_ = (unsigned)(idxl[16 * ((j4) * 4 + jj) + l15] * 256 + 16 * g); \
            _Pragma("unroll") for (int kk = 0; kk < 2; ++kk) kf[buf][jj][kk] = ldg<u32x4>(pk_, ko_, kk * 64); } } while (0)
        SP_LOADK(0, 0);
#pragma unroll
        for (int j4 = 0; j4 < 4; ++j4) {
            if (j4 + 1 < 4) SP_LOADK((j4 + 1) & 1, j4 + 1);
#pragma unroll
            for (int jj = 0; jj < 4; ++jj) { f32x4 a = {0.f, 0.f, 0.f, 0.f};
#pragma unroll
                for (int kk = 0; kk < 2; ++kk) { const u32x4 kv_ = kf[j4 & 1][jj][kk];
                    a = __builtin_amdgcn_mfma_f32_16x16x32_fp8_fp8(__builtin_bit_cast(long, (u32x2){kv_.x, kv_.y}), qf[kk][0], a, 0, 0, 0);
                    a = __builtin_amdgcn_mfma_f32_16x16x32_fp8_fp8(__builtin_bit_cast(long, (u32x2){kv_.z, kv_.w}), qf[kk][1], a, 0, 0, 0); }
                s[j4 * 4 + jj] = a; }
        }
#undef SP_LOADK
        u32x4 vst[2][4];
        const int l7 = lz_ & 7, k8 = lz_ >> 3;
#define SP_LOADV(buf, u) do { _Pragma("unroll") for (int i = 0; i < 4; ++i) { const unsigned vo_ = (unsigned)(idxl[32 * (u) + 8 * i + k8] * 256 + 128 + 16 * l7); vst[buf][i] = ldg<u32x4>(pk_, vo_); } } while (0)
        SP_LOADV(0, 0); SP_LOADV(1, 1);
        if (has_next) {
#pragma unroll
            for (int c = 0; c < 4; ++c) { const bool ok = (4 * F.lane + c) < nn; const int ii = ok ? nid[c] : 0; nid[c] = ii; nps[c] = F.pos[(tn / SEQ) * SEQ + ii]; } }
        float mx = -__builtin_inff();
#pragma unroll
        for (int jb = 0; jb < 16; ++jb) { const f32x4 dv = *(const LAS f32x4*)(distl + 16 * jb + 4 * g);
#pragma unroll
            for (int i = 0; i < 4; ++i) { const float v = s[jb][i] * qscale - slope2 * dv[i]; s[jb][i] = v; mx = fmaxf(mx, v); } }
        mx = fmaxf(mx, __shfl_xor(mx, 16)); mx = fmaxf(mx, __shfl_xor(mx, 32));
        float sum = 0.f;
#pragma unroll
        for (int jb = 0; jb < 16; ++jb)
#pragma unroll
            for (int i = 0; i < 4; ++i) { const float p = __builtin_amdgcn_exp2f(s[jb][i] - mx); s[jb][i] = p; sum += p; }
        sum += __shfl_xor(sum, 16); sum += __shfl_xor(sum, 32);
        bf16x8 pf[8];
#pragma unroll
        for (int u = 0; u < 8; ++u) { u32x4 w = {cvtpk(s[2 * u][0], s[2 * u][1]), cvtpk(s[2 * u][2], s[2 * u][3]), cvtpk(s[2 * u + 1][0], s[2 * u + 1][1]), cvtpk(s[2 * u + 1][2], s[2 * u + 1][3])};
            pf[u] = __builtin_bit_cast(bf16x8, w); }
        f32x4 o[8];
#pragma unroll
        for (int mb = 0; mb < 8; ++mb) o[mb] = (f32x4){0.f, 0.f, 0.f, 0.f};
#pragma unroll
        for (int u = 0; u < 8; ++u) {
#pragma unroll
            for (int i = 0; i < 4; ++i) { const u32x4 v_ = vst[u & 1][i];
                *(LAS bf16x8*)(vimg + offb(8 * i + k8, 2 * l7)) = sp_fp8_bf8((u32x2){v_.x, v_.y}); *(LAS bf16x8*)(vimg + offb(8 * i + k8, 2 * l7 + 1)) = sp_fp8_bf8((u32x2){v_.z, v_.w}); }
            if (u + 2 < 8) SP_LOADV(u & 1, u + 2);
#pragma unroll
            for (int mb = 0; mb < 8; ++mb) {
                const s16x4 lo = vtr(vimg + offb(4 * g + q4, 2 * mb + (p4 >> 1)) + 8 * (p4 & 1));
                const s16x4 hh = vtr(vimg + offb(16 + 4 * g + q4, 2 * mb + (p4 >> 1)) + 8 * (p4 & 1));
                const bf16x8 af = {lo[0], lo[1], lo[2], lo[3], hh[0], hh[1], hh[2], hh[3]};
                o[mb] = __builtin_amdgcn_mfma_f32_16x16x32_bf16(af, pf[u], o[mb], 0, 0, 0);
            }
        }
#undef SP_LOADV
        const float inv = 1.f / sum;
#pragma unroll
        for (int mb = 0; mb < 8; ++mb)
            *(unsigned*)(mix + (size_t)t * DM + l15 * 128 + 16 * mb + 4 * g) = pg8::pk4_fp8(o[mb][0] * inv, o[mb][1] * inv, o[mb][2] * inv, o[mb][3] * inv);
    }
}

namespace mla {
constexpr int KROW = 208, KBUF = 64 * KROW, VROW = 80, VBUF = 128 * VROW;
constexpr int L_K = 0, L_V = 2 * KBUF, L_CKT = L_V + 2 * VBUF, L_WS = L_CKT + 512, L_TL = L_WS + 8 * 256, L_TMX = L_TL + 512, L_END = L_TMX + 512;
static_assert(L_END <= RING_BYTES, "mla LDS map");
constexpr float SCALE = 0.07216878364870323f;
constexpr float THR = 6.f;
constexpr float MASKV = -30000.f;
constexpr int IMAX = 0x7fffffff;
DEV void partialSM(f32x16& p0, f32x16& p1, float& m_reg, float& mn, float& alpha) {
    constexpr float C = SCALE * 1.4426950408889634f;
    float pmax = p0[0];
#pragma unroll
    for (int r = 1; r < 16; ++r) pmax = fmaxf(pmax, p0[r]);
#pragma unroll
    for (int r = 0; r < 16; ++r) pmax = fmaxf(pmax, p1[r]);
    { auto rr = __builtin_amdgcn_permlane32_swap(__float_as_uint(pmax), __float_as_uint(pmax), false, false); pmax = fmaxf(__uint_as_float(rr[0]), __uint_as_float(rr[1])); }
    if (__builtin_expect(__all(pmax - m_reg <= THR / SCALE), 1)) { mn = m_reg; alpha = 1.f; }
    else { mn = fmaxf(m_reg, pmax); alpha = __builtin_amdgcn_exp2f((m_reg - mn) * C); m_reg = mn; }
    const float mnC = -mn * C;
    const f32x2 C2 = {C, C}, mn2 = {mnC, mnC};
#pragma unroll
    for (int r = 0; r < 16; r += 2) { const f32x2 t = __builtin_elementwise_fma((f32x2){p0[r], p0[r + 1]}, C2, mn2); p0[r] = t.x; p0[r + 1] = t.y; }
#pragma unroll
    for (int r = 0; r < 16; r += 2) { const f32x2 t = __builtin_elementwise_fma((f32x2){p1[r], p1[r + 1]}, C2, mn2); p1[r] = t.x; p1[r + 1] = t.y; }
#pragma unroll
    for (int r = 0; r < 16; ++r) p0[r] = __builtin_amdgcn_exp2f(p0[r]);
}
DEV void finishSM(f32x16& p0, f32x16& p1, float alpha, float& l_reg, pg8::v8i& P8) {
#pragma unroll
    for (int r = 0; r < 16; ++r) p1[r] = __builtin_amdgcn_exp2f(p1[r]);
    f32x2 s2 = (f32x2){p0[0], p0[1]} + (f32x2){p1[0], p1[1]};
#pragma unroll
    for (int r = 2; r < 16; r += 2) s2 += (f32x2){p0[r], p0[r + 1]} + (f32x2){p1[r], p1[r + 1]};
    float ps = s2.x + s2.y;
    { auto rr = __builtin_amdgcn_permlane32_swap(__float_as_uint(ps), __float_as_uint(ps), false, false); ps = __uint_as_float(rr[0]) + __uint_as_float(rr[1]); }
    l_reg = l_reg * alpha + ps;
#pragma unroll
    for (int w = 0; w < 4; ++w) { P8[w] = (int)pg8::pk4_fp8(p0[4 * w], p0[4 * w + 1], p0[4 * w + 2], p0[4 * w + 3]); P8[4 + w] = (int)pg8::pk4_fp8(p1[4 * w], p1[4 * w + 1], p1[4 * w + 2], p1[4 * w + 3]); }
}
DEV u32x2 bf8_fp8(bf16x8 v) { const u32x4 w = __builtin_bit_cast(u32x4, v); u32x2 r;
    r.x = __builtin_amdgcn_cvt_pk_fp8_f32(__uint_as_float(w.x << 16), __uint_as_float(w.x & 0xffff0000u), 0u, false);
    r.x = __builtin_amdgcn_cvt_pk_fp8_f32(__uint_as_float(w.y << 16), __uint_as_float(w.y & 0xffff0000u), r.x, true);
    r.y = __builtin_amdgcn_cvt_pk_fp8_f32(__uint_as_float(w.z << 16), __uint_as_float(w.z & 0xffff0000u), 0u, false);
    r.y = __builtin_amdgcn_cvt_pk_fp8_f32(__uint_as_float(w.w << 16), __uint_as_float(w.w & 0xffff0000u), r.y, true);
    return r; }
DEV void qkt(f32x16& p0, f32x16& p1, const LAS unsigned char* Ks, const pg8::v8i (&q8)[3], int r32, int hi) {
    p0 = (f32x16){}; p1 = (f32x16){};
#pragma unroll
    for (int c = 0; c < 3; ++c) { const int cb = c * 64 + hi * 32;
        const pg8::v8i b0 = *(const LAS pg8::v8i*)(Ks + r32 * KROW + cb);
        const pg8::v8i b1 = *(const LAS pg8::v8i*)(Ks + (32 + r32) * KROW + cb);
        p0 = __builtin_amdgcn_mfma_scale_f32_32x32x64_f8f6f4(b0, q8[c], p0, 0, 0, 0, 0x7f7f7f7f, 0, 0x7f7f7f7f);
        p1 = __builtin_amdgcn_mfma_scale_f32_32x32x64_f8f6f4(b1, q8[c], p1, 0, 0, 0, 0x7f7f7f7f, 0, 0x7f7f7f7f);
        if (c == 0) asm volatile("" :: "v"(b0), "v"(b1));
    }
}
DEV void maskt(f32x16& p0, f32x16& p1, const LAS int* ck64, int cq, int hi) {
#pragma unroll
    for (int r = 0; r < 16; ++r) { if (ck64[crow(r, hi)] > cq) p0[r] = MASKV; if (ck64[32 + crow(r, hi)] > cq) p1[r] = MASKV; }
}
DEV void pv_d0(f32x16 (&o)[4], const LAS unsigned char* vb, const pg8::v8i& P8) {
#pragma unroll
    for (int d = 0; d < 4; d += 2) { const pg8::v8i bv0 = *(const LAS pg8::v8i*)(vb + d * 32 * VROW), bv1 = *(const LAS pg8::v8i*)(vb + (d + 1) * 32 * VROW);
        o[d] = __builtin_amdgcn_mfma_scale_f32_32x32x64_f8f6f4(P8, bv0, o[d], 0, 0, 0, 0x7f7f7f7f, 0, 0x7f7f7f7f);
        o[d + 1] = __builtin_amdgcn_mfma_scale_f32_32x32x64_f8f6f4(P8, bv1, o[d + 1], 0, 0, 0, 0x7f7f7f7f, 0, 0x7f7f7f7f); }
}
}

DEV void mla_phase(const Frame& F) {
    using namespace mla;
    const bf16* qfp = wsp<bf16>(F, WS_QF); const unsigned char* kv = wsp<unsigned char>(F, WS_KV); const unsigned char* kro = wsp<unsigned char>(F, WS_KROPE8);
    const int* ck = wsp<int>(F, WS_CK); const int* tmm = wsp<int>(F, WS_TMM); const float* ct = wsp<float>(F, WS_COS); const float* st = wsp<float>(F, WS_SIN);
    unsigned char* mix = wsp<unsigned char>(F, WS_MIX);
    const int tid = F.tid, wid = F.wave, lane = F.lane, r32 = lane & 31, hi = lane >> 5;
    LAS unsigned char* Kl = F.lds + L_K; LAS unsigned char* Vl = F.lds + L_V; LAS int* ckt = (LAS int*)(F.lds + L_CKT);
    LAS float* li_l = (LAS float*)(F.lds + L_WS) + wid * 64; LAS float* al_l = li_l + 32;
    LAS int* tl = (LAS int*)(F.lds + L_TL); LAS int* tlmx = (LAS int*)(F.lds + L_TMX);
    const int vcu = (F.G % 8 == 0) ? (F.bid % 8) * (F.G / 8) + F.bid / 8 : F.bid;
    const int krow = tid >> 3, kc8 = tid & 7;
    const unsigned koff = (unsigned)(krow * NKV + kc8 * 8);
#pragma unroll 1
    for (int pp = vcu; pp < 512; pp += F.G) {
#pragma unroll 1
        for (int side = 0; side < 2; ++side) {
            const int bh = pp >> 3, pr = pp & 7, b = bh >> 4, h = bh & 15, qb = side ? 15 - pr : pr;
            const int trow0 = b * SEQ + qb * 256, trow = trow0 + wid * 32 + r32;
            const unsigned lz = opq((unsigned)lane), r32z = lz & 31u, hiz = lz >> 5;
            LAS unsigned char* vwr = Vl + (4 * r32z) * VROW + (wid & 1) * 32 + (wid >> 1) * 4 + 16 * hiz;
            const LAS unsigned char* vb0 = Vl + r32z * VROW + hiz * 32;
            const int cq = ldg<int>(ck + trow0 + wid * 32, r32z * 4u);
            const i32x4 c4 = ldg<i32x4>(ck + trow0, lz * 16u);
            int cmx = c4.x > c4.y ? c4.x : c4.y; cmx = cmx > c4.z ? cmx : c4.z; cmx = cmx > c4.w ? cmx : c4.w;
            const int cqmax = wave_max_i(cmx), wmin = wave_min_i(cq);
            const int tmn_l = ldg<int>(tmm + b * 64, lz * 4u), tmx_l = ldg<int>(tmm + 256 + b * 64, lz * 4u);
            const unsigned long long mask = __ballot(tmn_l <= cqmax);
            const int NT = __popcll(mask), NT2 = NT + (NT & 1);
            __syncthreads();
            if ((mask >> lz) & 1ull) { const int rank = (int)mbcnt64(mask); tl[rank] = (int)lz; tlmx[rank] = tmx_l; }
            if ((NT & 1) && lane == 0) { tl[NT] = 63 - __builtin_clzll(mask); tlmx[NT] = IMAX; }
            __syncthreads();
            bf16x8 qb16[12];
            { const unsigned qo = (r32z * NQF + hiz * 8) * 2u; const bf16* Qb = qfp + (size_t)(trow0 + wid * 32) * NQF + h * 192;
#pragma unroll
              for (int d0 = 0; d0 < 12; ++d0) qb16[d0] = ldg<bf16x8>(Qb, qo, d0 * 32);
              const unsigned co = (r32z * 32 + hiz * 8) * 4u; const float* cb_ = ct + (size_t)(trow0 + wid * 32) * 32; const float* sb_ = st + (size_t)(trow0 + wid * 32) * 32;
#pragma unroll
              for (int dd = 0; dd < 2; ++dd) {
                  const f32x4 c0 = ldg<f32x4>(cb_, co, dd * 64), c1 = ldg<f32x4>(cb_, co, dd * 64 + 16), s0 = ldg<f32x4>(sb_, co, dd * 64), s1 = ldg<f32x4>(sb_, co, dd * 64 + 16);
#pragma unroll
                  for (int e = 0; e < 8; ++e) { const float x1 = bf2f((unsigned short)qb16[8 + dd][e]), x2 = bf2f((unsigned short)qb16[10 + dd][e]);
                      const float c = e < 4 ? c0[e & 3] : c1[e & 3], s = e < 4 ? s0[e & 3] : s1[e & 3];
                      qb16[8 + dd][e] = (short)f2bf(x1 * c - x2 * s); qb16[10 + dd][e] = (short)f2bf(x1 * s + x2 * c); } } }
            pg8::v8i qr[3];
#pragma unroll
            for (int c = 0; c < 3; ++c) { const u32x2 a0 = bf8_fp8(qb16[4 * c]), a1 = bf8_fp8(qb16[4 * c + 1]), a2 = bf8_fp8(qb16[4 * c + 2]), a3 = bf8_fp8(qb16[4 * c + 3]);
                qr[c] = (pg8::v8i){(int)a0.x, (int)a0.y, (int)a1.x, (int)a1.y, (int)a2.x, (int)a2.y, (int)a3.x, (int)a3.y}; }
            float m_reg = -1e30f, l_reg = 0.f; f32x16 o[4] = {};
            u32x2 sk0, sk1, sk2; unsigned sv[4]; int sck = 0;
#define SLOAD(i) do { const int tj_ = __builtin_amdgcn_readfirstlane(tl[i]), kmx_ = __builtin_amdgcn_readfirstlane(tlmx[i]); const unsigned keyb_ = (unsigned)(b * SEQ + tj_ * 64); \
        const unsigned char* kb_ = kv + (size_t)keyb_ * NKV + h * 128; const unsigned ko_ = opq(koff), lo_ = opq((unsigned)lane), vo_ = (lo_ >> 5) * (32u * NKV) + (lo_ & 31u) * 4u, to_ = opq((unsigned)tid); \
        sk0 = ldg<u32x2>(kb_, ko_); sk1 = ldg<u32x2>(kb_, ko_, 64); sk2 = ldg<u32x2>(kro + (size_t)keyb_ * 64, to_ * 8u); \
        { const unsigned char* vb_ = kb_ + 2048 + (size_t)(4 * wid) * NKV; _Pragma("unroll") for (int b_ = 0; b_ < 4; ++b_) sv[b_] = ldg<unsigned>(vb_ + (size_t)b_ * NKV, vo_); } \
        if (tid < 64) sck = (kmx_ == IMAX) ? IMAX : ldg<int>(ck + keyb_, to_ * 4u); } while (0)
#define SWRITE(buf) do { LAS unsigned char* kb_ = Kl + (buf) * KBUF + krow * KROW + (kc8 & 1) * 32 + (kc8 >> 1) * 8; *(LAS u32x2*)kb_ = sk0; *(LAS u32x2*)(kb_ + 64) = sk1; *(LAS u32x2*)(kb_ + 128) = sk2; \
        { const unsigned t0_ = __builtin_amdgcn_perm(sv[1], sv[0], 0x05010400u), t1_ = __builtin_amdgcn_perm(sv[1], sv[0], 0x07030602u), u0_ = __builtin_amdgcn_perm(sv[3], sv[2], 0x05010400u), u1_ = __builtin_amdgcn_perm(sv[3], sv[2], 0x07030602u); \
          *(LAS unsigned*)(vwr + (buf) * VBUF) = __builtin_amdgcn_perm(u0_, t0_, 0x05040100u); *(LAS unsigned*)(vwr + (buf) * VBUF + VROW) = __builtin_amdgcn_perm(u0_, t0_, 0x07060302u); \
          *(LAS unsigned*)(vwr + (buf) * VBUF + 2 * VROW) = __builtin_amdgcn_perm(u1_, t1_, 0x05040100u); *(LAS unsigned*)(vwr + (buf) * VBUF + 3 * VROW) = __builtin_amdgcn_perm(u1_, t1_, 0x07060302u); } \
        if (tid < 64) ckt[(buf) * 64 + tid] = sck; } while (0)
#define RESC(a) do { if (__any((a) < 1.f)) { if (hi == 0) al_l[r32] = (a); asm volatile("s_waitcnt lgkmcnt(0)" ::: "memory"); \
        _Pragma("unroll") for (int d = 0; d < 4; ++d) _Pragma("unroll") for (int r = 0; r < 16; ++r) o[d][r] *= al_l[crow(r, hi)]; } } while (0)
#define MASKIF(P0, P1, i, buf) do { if (__builtin_amdgcn_readfirstlane(tlmx[i]) > wmin) maskt(P0, P1, ckt + (buf) * 64, cq, hi); } while (0)
            f32x16 pA0, pA1, pB0, pB1; float mnA, mnB, alA, alB; pg8::v8i P8;
            SLOAD(0); SWRITE(0); __syncthreads();
            qkt(pA0, pA1, Kl, qr, r32, hi); MASKIF(pA0, pA1, 0, 0); partialSM(pA0, pA1, m_reg, mnA, alA);
            SLOAD(1); SWRITE(1); __syncthreads();
#pragma unroll 1
            for (int j = 1; j + 1 < NT2; j += 2) {
                SBAR(); qkt(pB0, pB1, Kl + KBUF, qr, r32, hi); MASKIF(pB0, pB1, j, 1);
                finishSM(pA0, pA1, alA, l_reg, P8); SBAR();
                SLOAD(j + 1); SBAR();
                pv_d0(o, vb0, P8); partialSM(pB0, pB1, m_reg, mnB, alB);
                __syncthreads(); SWRITE(0);
                RESC(alB); __syncthreads();
                SBAR(); qkt(pA0, pA1, Kl, qr, r32, hi); MASKIF(pA0, pA1, j + 1, 0);
                finishSM(pB0, pB1, alB, l_reg, P8); SBAR();
                SLOAD(j + 2); SBAR();
                pv_d0(o, vb0 + VBUF, P8); partialSM(pA0, pA1, m_reg, mnA, alA);
                __syncthreads(); SWRITE(1);
                RESC(alA); __syncthreads();
            }
            SBAR(); qkt(pB0, pB1, Kl + KBUF, qr, r32, hi); MASKIF(pB0, pB1, NT2 - 1, 1);
            finishSM(pA0, pA1, alA, l_reg, P8); SBAR();
            pv_d0(o, vb0, P8); partialSM(pB0, pB1, m_reg, mnB, alB);
            __syncthreads(); RESC(alB);
            finishSM(pB0, pB1, alB, l_reg, P8); SBAR();
            pv_d0(o, vb0 + VBUF, P8);
            if (hi == 0) li_l[r32] = l_reg; asm volatile("s_waitcnt lgkmcnt(0)" ::: "memory");
            float rli[16];
#pragma unroll
            for (int r = 0; r < 16; ++r) rli[r] = __builtin_amdgcn_rcpf(li_l[crow(r, hi)]);
            unsigned char* Ow = mix + (size_t)trow0 * DM + 2048 + h * 128; const unsigned lq = opq((unsigned)lane); unsigned oo = (unsigned)((wid * 32 + 4 * (lq >> 5)) * DM + (lq & 31u));
            asm volatile("" : "+v"(oo));
#pragma unroll
            for (int r = 0; r < 16; ++r) { const unsigned ro = oo + (unsigned)(((r & 3) + 8 * (r >> 2)) * DM); const float rs16 = rli[r] * 16.f;
                const unsigned w01 = __builtin_amdgcn_cvt_pk_fp8_f32(o[0][r] * rs16, o[1][r] * rs16, 0u, false), w23 = __builtin_amdgcn_cvt_pk_fp8_f32(o[2][r] * rs16, o[3][r] * rs16, 0u, false);
                stg<unsigned char>(Ow, ro, 0, (unsigned char)(w01 & 0xffu)); stg<unsigned char>(Ow, ro, 32, (unsigned char)((w01 >> 8) & 0xffu));
                stg<unsigned char>(Ow, ro, 64, (unsigned char)(w23 & 0xffu)); stg<unsigned char>(Ow, ro, 96, (unsigned char)((w23 >> 8) & 0xffu)); }
#undef SLOAD
#undef SWRITE
#undef RESC
#undef MASKIF
        }
    }
}

#define GAS __attribute__((address_space(1)))
typedef const __attribute__((address_space(4))) unsigned long long* KArgP;
DEV KArgP kargs_fresh() {
    const unsigned long long p = (unsigned long long)__builtin_amdgcn_kernarg_segment_ptr(); unsigned lo = (unsigned)p, hi = (unsigned)(p >> 32);
    asm volatile("" : "+v"(lo), "+v"(hi)); lo = __builtin_amdgcn_readfirstlane(lo); hi = __builtin_amdgcn_readfirstlane(hi);
    return (KArgP)(((unsigned long long)hi << 32) | lo);
}
#define LOADP() do { const KArgP ka_ = kargs_fresh(); F.x = (const float*)(GAS const float*)ka_[0]; F.c = (const float*)(GAS const float*)ka_[1]; F.pos = (const int*)(GAS const int*)ka_[2]; F.w_ada = (const float*)(GAS const float*)ka_[3]; F.b_ada = (const float*)(GAS const float*)ka_[4]; F.ln1_g = (const float*)(GAS const float*)ka_[5]; F.w_in = (const float*)(GAS const float*)ka_[6]; F.q_norm_g = (const float*)(GAS const float*)ka_[7]; F.kv_norm_g = (const float*)(GAS const float*)ka_[8]; F.w_uq = (const float*)(GAS const float*)ka_[9]; F.w_uk = (const float*)(GAS const float*)ka_[10]; F.w_uv = (const float*)(GAS const float*)ka_[11]; F.w_o = (const float*)(GAS const float*)ka_[12]; F.ln2_g = (const float*)(GAS const float*)ka_[13]; F.w_up = (const float*)(GAS const float*)ka_[14]; F.w_dn = (const float*)(GAS const float*)ka_[15]; F.final_g = (const float*)(GAS const float*)ka_[16]; } while (0)
constexpr int N_PHASES = 12;
__global__ void __launch_bounds__(512, 2) mk_fwd(Args args) {
    extern __shared__ __attribute__((aligned(16))) unsigned char lds_raw[];
    Frame F;
    F.lds = (LAS unsigned char*)lds_raw;
    F.tid = threadIdx.x; F.lane = F.tid & 63; F.wave = __builtin_amdgcn_readfirstlane(F.tid >> 6); F.G = gridDim.x; F.bid = blockIdx.x;
    F.x = F.c = F.w_ada = F.b_ada = F.ln1_g = F.w_in = F.q_norm_g = F.kv_norm_g = F.w_uq = F.w_uk = F.w_uv = F.w_o = F.ln2_g = F.w_up = F.w_dn = F.final_g = nullptr; F.pos = nullptr;
    F.out = args.out; F.ws = args.ws;
    volatile LAS unsigned* MISC = (volatile LAS unsigned*)(F.lds + MISC_OFF);
    if (F.tid < 32) MISC[F.tid] = 0u;
    __syncthreads();
    const int lo = args.ph_lo, hi = args.ph_hi;
    XcdBarrier bar; bar.bar = (unsigned*)(F.ws + WS_CTL) + CW_BAR; bar.x = 0; bar.st = nullptr;
    if (hi - lo > 1) bar = xcd_barrier_post((unsigned*)(F.ws + WS_CTL) + CW_BAR, MISC + 8);
#ifndef PHASE_MASK
#define PHASE_MASK 0xFFFF
#endif
#define IN(k) (((PHASE_MASK >> (k)) & 1) && lo <= (k) && (k) < hi)
#ifndef REP_PHASE
#define REP_PHASE -1
#endif
#ifndef REP_SUB
#define REP_SUB 0
#endif
#define NREP(k) ((REP_PHASE == (k)) ? 2 : 1)
#ifndef REP_BAR
#define REP_BAR 0
#endif
#define SEAM(k) do { if (IN(k) && IN((k) + 1)) { xcd_barrier(bar); if (REP_BAR) { xcd_barrier(bar); xcd_barrier(bar); } } } while (0)
    LAS unsigned char* ring = F.lds;
#define FRESH() do { unsigned lo_ = (unsigned)(unsigned long long)F.ws, hi_ = (unsigned)((unsigned long long)F.ws >> 32); asm volatile("" : "+v"(lo_), "+v"(hi_)); lo_ = __builtin_amdgcn_readfirstlane(lo_); hi_ = __builtin_amdgcn_readfirstlane(hi_); F.ws = (unsigned char*)(((unsigned long long)hi_ << 32) | lo_); } while (0)
    for (int rep_ = 0; IN(0) && rep_ < NREP(0); ++rep_) { if (rep_) __syncthreads(); LOADP(); p0_mod(F); __syncthreads(); p0_weights(F); __syncthreads(); p0_colmax(F); } SEAM(0);
    for (int rep_ = 0; IN(1) && rep_ < NREP(1); ++rep_) { if (rep_) __syncthreads(); LOADP(); p1_win(F); __syncthreads(); p_adaln<3, false>(F, F.x, F.ln1_g, 0, 1, true); } SEAM(1);
    for (int rep_ = 0; IN(2) && rep_ < NREP(2); ++rep_) { if (rep_) __syncthreads(); LOADP(); { pg8::Gemm g{wsp<unsigned char>(F, WS_H), wsp<unsigned char>(F, WS_WIN), M, NA, DM, DM, DM, 0}; pg8::StaticOrder S; S.init(M, NA, F.G, F.bid);
          pg8::EpiBf16<5> E{wsp<bf16>(F, WS_PA), NA, wsp<float>(F, WS_RSA), wsp<float>(F, WS_CSB), wsp<unsigned char>(F, WS_KAV8)}; pg8::gemm_phase<3>(ring, g, S, E); }
        { pg8::Gemm g{wsp<unsigned char>(F, WS_H), wsp<unsigned char>(F, WS_WINB), M, NBQ, DM, DM, DM, 0}; pg8::StaticOrder S; S.init(M, NBQ, F.G, F.bid);
          pg8::EpiBf16<3> E{wsp<bf16>(F, WS_PB), NBQ, wsp<float>(F, WS_RSA), wsp<float>(F, WS_CSB) + NA}; pg8::gemm_phase<3>(ring, g, S, E); } } SEAM(2);
    for (int rep_ = 0; IN(3) && rep_ < NREP(3); ++rep_) { if (rep_) __syncthreads(); LOADP(); p2_rowstats(F); } SEAM(3);
    for (int rep_ = 0; IN(4) && rep_ < NREP(4); ++rep_) { if (rep_) __syncthreads();
        { pg8::Gemm g{wsp<unsigned char>(F, WS_CQ8), wsp<unsigned char>(F, WS_WUQ), M, NQF, QLORA, QLORA, QLORA, 0}; pg8::StaticOrder S; S.init(M, NQF, F.G, F.bid);
          pg8::EpiBf16<3> E{wsp<bf16>(F, WS_QF), NQF, wsp<float>(F, WS_RSQ), wsp<float>(F, WS_CSU)}; pg8::gemm_phase<3>(ring, g, S, E); }
        { pg8::Gemm g{wsp<unsigned char>(F, WS_CKV8), wsp<unsigned char>(F, WS_WUKV), M, NKV, KVLORA, KVLORA, KVLORA, 0}; pg8::StaticOrder S; S.init(M, NKV, F.G, F.bid);
          pg8::EpiFp8Deq E{wsp<unsigned char>(F, WS_KV), NKV, wsp<float>(F, WS_RSKV), wsp<float>(F, WS_CSU) + NQF}; pg8::gemm_phase<3>(ring, g, S, E); }
        idx_phase<0>(F);
    } SEAM(4);
#ifndef P5SEL
#define P5SEL 3
#endif
    for (int rep_ = 0; IN(5) && rep_ < NREP(5); ++rep_) { if (rep_) __syncthreads(); LOADP(); sparse_phase<true>(F); __syncthreads();   mla_phase(F); } SEAM(5);
    for (int rep_ = 0; IN(7) && rep_ < NREP(7); ++rep_) { if (rep_) __syncthreads(); LOADP(); pg8::Gemm g{wsp<unsigned char>(F, WS_MIX), wsp<unsigned char>(F, WS_WO), M, DM, DM, DM, DM, 0}; pg8::StaticOrder S; S.init(M, DM, F.G, F.bid);
        pg8::EpiResGate<false> E{F.x, wsp<bf16>(F, WS_X1), DM, wsp<float>(F, WS_GATE)}; pg8::gemm_phase<true, pg8::EpiResGate<false>, pg8::StaticOrder, 0x78787878>(ring, g, S, E); } SEAM(7);
    for (int rep_ = 0; IN(8) && rep_ < NREP(8); ++rep_) { if (rep_) __syncthreads(); LOADP(); p_adaln<1, true>(F, wsp<bf16>(F, WS_X1), F.ln2_g, 3, 4, false); } SEAM(8);
    for (int rep_ = 0; IN(9) && rep_ < NREP(9); ++rep_) { if (rep_) __syncthreads(); LOADP(); pg8::Gemm g{wsp<unsigned char>(F, WS_H), wsp<unsigned char>(F, WS_WUP), M, DFF, DM, DM, DM, 0}; pg8::StaticOrder S; S.init(M, DFF, F.G, F.bid);
        pg8::EpiFp8Relu2 E{wsp<unsigned char>(F, WS_HID), DFF}; pg8::gemm_phase<true, pg8::EpiFp8Relu2, pg8::StaticOrder, 0x78787878>(ring, g, S, E); } SEAM(9);
    for (int rep_ = 0; IN(10) && rep_ < NREP(10); ++rep_) { if (rep_) __syncthreads(); LOADP(); pg8::Gemm g{wsp<unsigned char>(F, WS_HID), wsp<unsigned char>(F, WS_WDN), M, DM, DFF, DFF, DFF, 0x77777777};    pg8::StaticOrder S; S.init(M, DM, F.G, F.bid);
        pg8::EpiResGate<true> E{wsp<bf16>(F, WS_X1), wsp<bf16>(F, WS_X2), DM, wsp<float>(F, WS_GATE) + NB * DM}; pg8::gemm_phase<true, pg8::EpiResGate<true>, pg8::StaticOrder, 0x77777777>(ring, g, S, E); } SEAM(10);
    for (int rep_ = 0; IN(11) && rep_ < NREP(11); ++rep_) { if (rep_) __syncthreads(); LOADP(); p_final(F); }
#undef IN
#undef SEAM
}


#ifndef DBG
#define DBG 0
#endif
#if DBG
constexpr int DBG_ERRW = 8192;
__device__ unsigned dbg_hash(unsigned x) { x ^= x >> 16; x *= 0x7feb352du; x ^= x >> 15; x *= 0x846ca68bu; x ^= x >> 16; return x; }
__device__ float dbg_bsum(float v, float* sh) {
    __syncthreads(); sh[threadIdx.x] = v; __syncthreads();
    for (int o = 128; o > 0; o >>= 1) { if ((int)threadIdx.x < o) sh[threadIdx.x] += sh[threadIdx.x + o]; __syncthreads(); }
    const float r = sh[0]; __syncthreads(); return r;
}
__device__ float dbg_bmax(float v, float* sh) {
    __syncthreads(); sh[threadIdx.x] = v; __syncthreads();
    for (int o = 128; o > 0; o >>= 1) { if ((int)threadIdx.x < o) sh[threadIdx.x] = fmaxf(sh[threadIdx.x], sh[threadIdx.x + o]); __syncthreads(); }
    const float r = sh[0]; __syncthreads(); return r;
}
__device__ void dbg_report(unsigned* errw, float got, float ref, float S) {
    float e = fabsf(got - ref) / (fabsf(ref) + S); if (!(e == e)) e = 100.f; if (e > 100.f) e = 100.f;
    atomicMax(errw, __float_as_uint(e));
}
__global__ void __launch_bounds__(256) dbg_kernel(Args args, int which) {
    __shared__ float sh[256]; __shared__ float shv[4096];
    Frame F; F.ws = args.ws; F.out = args.out;
    const float* x = (const float*)args.in[0]; const float* c = (const float*)args.in[1]; const int* pos = (const int*)args.in[2];
    const float* w_ada = (const float*)args.in[3]; const float* b_ada = (const float*)args.in[4]; const float* ln1_g = (const float*)args.in[5]; const float* w_in = (const float*)args.in[6];
    const float* qg = (const float*)args.in[7]; const float* kvg = (const float*)args.in[8]; const float* w_uq = (const float*)args.in[9]; const float* w_uk = (const float*)args.in[10]; const float* w_uv = (const float*)args.in[11];
    unsigned* errw = (unsigned*)(args.ws + WS_CTL) + DBG_ERRW;
    const int tid = threadIdx.x; const unsigned hs = dbg_hash(blockIdx.x * 2654435761u + 12345u);
    const bf16* H = wsp<bf16>(F, WS_H); const bf16* pa = wsp<bf16>(F, WS_PA); const bf16* pb = wsp<bf16>(F, WS_PB); const bf16* qf = wsp<bf16>(F, WS_QF); const bf16* kv = wsp<bf16>(F, WS_KV);
    const unsigned char* kv8 = wsp<unsigned char>(F, WS_KV); auto f8f = [](unsigned char v) -> float { return __builtin_amdgcn_cvt_f32_fp8((int)v, 0); };
    const bf16* kro = wsp<bf16>(F, WS_KROPE); const unsigned char* mix = wsp<unsigned char>(F, WS_MIX); const float* sc = wsp<float>(F, WS_SC); const int* idx = wsp<int>(F, WS_IDX); const int* cnt = wsp<int>(F, WS_CNT);
    if (which == 1) {
        const int row = hs % M, col = dbg_hash(hs) % DM, b = row / SEQ;
        float ss = 0.f, d1 = 0.f, d0 = 0.f;
        for (int d = tid; d < DM; d += 256) { const float xv = x[(size_t)row * DM + d]; ss += xv * xv; const float cv = c[b * DM + d], sl = cv / (1.f + expf(-cv));
            d1 += sl * w_ada[(size_t)d * 6 * DM + 1 * DM + col]; d0 += sl * w_ada[(size_t)d * 6 * DM + 0 * DM + col]; }
        ss = dbg_bsum(ss, sh); d1 = dbg_bsum(d1, sh); d0 = dbg_bsum(d0, sh);
        if (tid == 0) { const float rstd = 1.f / sqrtf(ss / DM + EPS); const float ref = x[(size_t)row * DM + col] * rstd * ln1_g[col] * (1.f + d1 + b_ada[DM + col]) + d0 + b_ada[col];
            dbg_report(errw, bf2f(H[(size_t)row * DM + col]), ref, 1.f); }
    } else if (which == 2) {
        const int specials[18] = {0, 2047, 2048, 2175, 2176, 2303, 2304, 6399, 6400, 6527, 6528, 6559, 6560, 7583, 7584, 8095, 8096, 8159};
        const int row = hs % M; const int col = (blockIdx.x < 72) ? specials[blockIdx.x % 18] : (int)(dbg_hash(hs) % INW);
        float a = 0.f; { const signed char* H8i = (const signed char*)wsp<unsigned char>(F, WS_H); const float sa = wsp<float>(F, WS_RSA)[row];
          for (int d = tid; d < DM; d += 256) a += (float)H8i[(size_t)row * DM + d] * sa * w_in[(size_t)d * INW + col]; }
        a = dbg_bsum(a, sh);
        if (tid == 0) { float got;
            if (col < C_KA) got = bf2f(pb[(size_t)row * NBQ + B_QA + col]); else if (col < C_VA) got = bf2f(pa[(size_t)row * NA + A_KA + col - C_KA]); else if (col < C_QI) got = bf2f(pa[(size_t)row * NA + A_VA + col - C_VA]);
            else if (col < C_KI) got = bf2f(pa[(size_t)row * NA + A_QI + col - C_QI]); else if (col < C_WI) got = bf2f(pa[(size_t)row * NA + A_KI + col - C_KI]); else if (col < C_CQ) got = bf2f(pa[(size_t)row * NA + A_WI + col - C_WI]);
            else if (col < C_CKV) got = bf2f(pb[(size_t)row * NBQ + B_CQ + col - C_CQ]); else if (col < C_KR) got = bf2f(pa[(size_t)row * NA + A_CKV + col - C_CKV]); else got = bf2f(pa[(size_t)row * NA + A_KR + col - C_KR]);
            dbg_report(errw, got, a, 1.f); }
    } else if (which == 3) {
        const int row = hs % M; const int sel = blockIdx.x % 3;
        if (sel == 0) { const int col = dbg_hash(hs) % NQF; float ss = 0.f, a = 0.f;
            for (int r = tid; r < QLORA; r += 256) { const float v = bf2f(pb[(size_t)row * NBQ + B_CQ + r]); ss += v * v; a += v * qg[r] * w_uq[(size_t)r * NQF + col]; }
            ss = dbg_bsum(ss, sh); a = dbg_bsum(a, sh); if (tid == 0) dbg_report(errw, bf2f(qf[(size_t)row * NQF + col]), a / sqrtf(ss / QLORA + EPS), 1.f);
        } else if (sel == 1) { const int col = dbg_hash(hs) % NKV; float ss = 0.f, a = 0.f;
            for (int r = tid; r < KVLORA; r += 256) { const float v = bf2f(pa[(size_t)row * NA + A_CKV + r]); ss += v * v; a += v * kvg[r] * (col < 2048 ? w_uk[(size_t)r * 2048 + col] : w_uv[(size_t)r * 2048 + col - 2048]); }
            ss = dbg_bsum(ss, sh); a = dbg_bsum(a, sh); if (tid == 0) dbg_report(errw, f8f(kv8[(size_t)row * NKV + col]), a / sqrtf(ss / KVLORA + EPS), 1.f);
        } else { if (tid < 32) { const double inv = pow(10000.0, -(double)(2 * tid) / 64.0), ang = (double)pos[row] * inv; const float cs = (float)cos(ang), sn = (float)sin(ang);
            const float x1 = bf2f(pa[(size_t)row * NA + A_KR + tid]), x2 = bf2f(pa[(size_t)row * NA + A_KR + 32 + tid]);
            dbg_report(errw, bf2f(kro[(size_t)row * 64 + tid]), x1 * cs - x2 * sn, 1.f); dbg_report(errw, bf2f(kro[(size_t)row * 64 + 32 + tid]), x1 * sn + x2 * cs, 1.f); } }
    } else if (which == 4) {
        int t = hs % M; if (blockIdx.x < 16) t = (blockIdx.x & 3) * SEQ + (blockIdx.x >> 2) * 63 + (blockIdx.x >> 2);
        const int h = dbg_hash(hs) % 16, b = t / SEQ; const int cq = pos[t] >> 6;
        float* q = shv;
        if (tid < 192) { float v = bf2f(qf[(size_t)t * NQF + h * 192 + tid]);
            if (tid >= 128) { const int i = (tid - 128) & 31; const double inv = pow(10000.0, -(double)(2 * i) / 64.0), ang = (double)pos[t] * inv; const float cs = (float)cos(ang), sn = (float)sin(ang);
                const float x1 = bf2f(qf[(size_t)t * NQF + h * 192 + 128 + i]), x2 = bf2f(qf[(size_t)t * NQF + h * 192 + 160 + i]); v = (tid < 160) ? x1 * cs - x2 * sn : x1 * sn + x2 * cs; }
            q[tid] = v; }
        __syncthreads();
        float* scs = shv + 256;
        float mx = -1e30f;
        for (int s = tid; s < SEQ; s += 256) { if ((pos[b * SEQ + s] >> 6) <= cq) { float a = 0.f; const unsigned char* kp = kv8 + (size_t)(b * SEQ + s) * NKV + h * 128; const bf16* rp = kro + (size_t)(b * SEQ + s) * 64;
            for (int d = 0; d < 128; ++d) a += q[d] * f8f(kp[d]); for (int d = 0; d < 64; ++d) a += q[128 + d] * bf2f(rp[d]); a *= 0.07216878364870323f; mx = fmaxf(mx, a); } }
        mx = dbg_bmax(mx, sh);
        float den = 0.f; float o0 = 0.f;
        float acc = 0.f;
        for (int s0 = 0; s0 < SEQ; s0 += 256) { const int s = s0 + tid; float pw = 0.f;
            if ((pos[b * SEQ + s] >> 6) <= cq) { float a = 0.f; const unsigned char* kp = kv8 + (size_t)(b * SEQ + s) * NKV + h * 128; const bf16* rp = kro + (size_t)(b * SEQ + s) * 64;
                for (int d = 0; d < 128; ++d) a += q[d] * f8f(kp[d]); for (int d = 0; d < 64; ++d) a += q[128 + d] * bf2f(rp[d]); a *= 0.07216878364870323f; pw = expf(a - mx); }
            den += pw; __syncthreads(); scs[tid] = pw; __syncthreads();
            if (tid < 128) for (int j = 0; j < 256; ++j) { const float pj = scs[j]; if (pj != 0.f) acc += pj * f8f(kv8[(size_t)(b * SEQ + s0 + j) * NKV + 2048 + h * 128 + tid]); } }
        den = dbg_bsum(den, sh); (void)o0;
        { float en = 0.f, ed = 0.f;
          if (tid < 128) { const float got = __builtin_amdgcn_cvt_f32_fp8((int)mix[(size_t)t * DM + 2048 + h * 128 + tid], 0) * (1.f / 16.f), ref = acc / den; en = (got - ref) * (got - ref); ed = ref * ref; }
          en = dbg_bsum(en, sh); ed = dbg_bsum(ed, sh);
          if (tid == 0) { float e = sqrtf(en / (ed + 1e-12f)); if (!(e == e)) e = 100.f; atomicMax(errw, __float_as_uint(e)); } }
    } else if (which == 5) {
        const int t = hs % M, b = t / SEQ; const int tq = t % SEQ; const int s = dbg_hash(hs) % ((tq / 64 + 1) * 64);
        float a = 0.f;
        if (tid < 32) { float dot = 0.f; for (int d = 0; d < 128; ++d) dot += bf2f(pa[(size_t)t * NA + A_QI + tid * 128 + d]) * bf2f(pa[(size_t)(b * SEQ + s) * NA + A_KI + d]);
            a = bf2f(pa[(size_t)t * NA + A_WI + tid]) * fmaxf(dot, 0.f); }
        float aa = dbg_bsum(fabsf(a), sh); a = dbg_bsum(a, sh);
        if (tid == 0) { float e = fabsf(sc[(size_t)t * SEQ + s] - a) / (aa + 1e-3f); if (!(e == e)) e = 100.f; atomicMax(errw, __float_as_uint(fminf(e, 100.f))); }
    } else if (which == 6) {
        int t = hs % M; if (blockIdx.x < 16) t = (blockIdx.x & 3) * SEQ + (blockIdx.x >> 2) * 50;
        const int b = t / SEQ, cq = pos[t] >> 6; const int n = cnt[t];
        float nadm = 0.f; for (int s = tid; s < SEQ; s += 256) nadm += ((pos[b * SEQ + s] >> 6) <= cq) ? 1.f : 0.f;
        nadm = dbg_bsum(nadm, sh); const int want = (int)nadm < TOPK ? (int)nadm : TOPK;
        float bad = (n != want) ? 1.f : 0.f; float ranksum = 0.f;
        if (tid < n && n <= TOPK) { const int k = idx[(size_t)t * TOPK + tid]; if (k < 0 || k >= SEQ || (pos[b * SEQ + k] >> 6) > cq) bad = 1.f; else { const float v = sc[(size_t)t * SEQ + k]; int rank = 0;
            for (int s = 0; s < SEQ; ++s) if ((pos[b * SEQ + s] >> 6) <= cq) { const float w = sc[(size_t)t * SEQ + s]; if (w > v || (w == v && s < k)) ++rank; }
            if (rank >= n) bad = 1.f; ranksum = (float)rank; } }
        bad = dbg_bmax(bad, sh); ranksum = dbg_bsum(ranksum, sh);
        if (tid == 0) { float e = bad; if (ranksum != (float)(n * (n - 1) / 2)) e = 2.f; atomicMax(errw, __float_as_uint(e)); }
    } else if (which == 8) {
        if (blockIdx.x == 0 && tid < 64) { const int l = tid, r = l & 31, h = l >> 5;
            auto fa = [](int i, int hh, int pp) -> int { return ((i * 7 + hh * 13 + pp * 3) % 5) - 2; };
            auto fb = [](int j, int hh, int pp) -> int { return ((j * 5 + hh * 11 + pp * 7) % 7) - 3; };
            pg8::v8i A, Bq;
            for (int w = 0; w < 8; ++w) { unsigned wa = 0u, wb = 0u;
                wa = __builtin_amdgcn_cvt_pk_fp8_f32((float)fa(r, h, 4 * w), (float)fa(r, h, 4 * w + 1), wa, false); wa = __builtin_amdgcn_cvt_pk_fp8_f32((float)fa(r, h, 4 * w + 2), (float)fa(r, h, 4 * w + 3), wa, true);
                wb = __builtin_amdgcn_cvt_pk_fp8_f32((float)fb(r, h, 4 * w), (float)fb(r, h, 4 * w + 1), wb, false); wb = __builtin_amdgcn_cvt_pk_fp8_f32((float)fb(r, h, 4 * w + 2), (float)fb(r, h, 4 * w + 3), wb, true);
                A[w] = (int)wa; Bq[w] = (int)wb; }
            f32x16 d = {}; asm volatile("" : "+v"(d));
            d = __builtin_amdgcn_mfma_scale_f32_32x32x64_f8f6f4(A, Bq, d, 0, 0, 0, 0x7f7f7f7f, 0, 0x7f7f7f7f);
            float bad = 0.f;
            for (int rg = 0; rg < 16; ++rg) { const int i = (rg & 3) + 8 * (rg >> 2) + 4 * h, j = r; int ex = 0;
                for (int hh = 0; hh < 2; ++hh) for (int pp = 0; pp < 32; ++pp) ex += fa(i, hh, pp) * fb(j, hh, pp);
                if (d[rg] != (float)ex) bad = 0.1f; }
            atomicMax(errw, __float_as_uint(bad)); }
    } else if (which == 7) {
        int t = hs % M; if (blockIdx.x < 16) t = (blockIdx.x & 3) * SEQ + (blockIdx.x >> 2) * 50;
        const int h = dbg_hash(hs) % 16, b = t / SEQ, n = cnt[t]; const float slope = exp2f(-0.5f * (float)(h + 1));
        float sv = -1e30f; int k = 0;
        if (tid < n) { k = idx[(size_t)t * TOPK + tid]; float a = 0.f; for (int d = 0; d < 128; ++d) a += bf2f(pb[(size_t)t * NBQ + B_QA + h * 128 + d]) * bf2f(pa[(size_t)(b * SEQ + k) * NA + A_KA + d]);
            sv = a * 0.088388347648318440f - slope * fabsf((float)(pos[t] - pos[b * SEQ + k])); }
        const float mx = dbg_bmax(sv, sh); const float pw = (tid < n) ? expf(sv - mx) : 0.f; const float den = dbg_bsum(pw, sh);
        shv[tid] = pw; ((int*)shv)[256 + tid] = k; __syncthreads();
        { float en = 0.f, ed = 0.f;
          if (tid < 128) { float acc = 0.f; for (int j = 0; j < n; ++j) acc += shv[j] * bf2f(pa[(size_t)(b * SEQ + ((int*)shv)[256 + j]) * NA + A_VA + tid]);
              const float got = __builtin_amdgcn_cvt_f32_fp8((int)mix[(size_t)t * DM + h * 128 + tid], 0), ref = acc / den; en = (got - ref) * (got - ref); ed = ref * ref; }
          en = dbg_bsum(en, sh); ed = dbg_bsum(ed, sh);
          if (tid == 0) { float e = sqrtf(en / (ed + 1e-12f)); if (!(e == e)) e = 100.f; atomicMax(errw, __float_as_uint(e)); } }
    }
}
__global__ void dbg_apply(float* out, const unsigned* errw, size_t n) {
    const float e = __uint_as_float(errw[0]); const float f = fminf(3.f, e * 10.f);
    for (size_t i = (size_t)blockIdx.x * blockDim.x + threadIdx.x; i < n; i += (size_t)gridDim.x * blockDim.x) out[i] *= (1.f + f);
}
#ifndef DBG_HI
#define DBG_HI (DBG == 1 ? 2 : (DBG == 2 ? 3 : 7))
#endif
#endif

extern "C" void kernel_launch(void* const* d_in, const int* in_sizes, int n_in, void* d_out, int out_size, void* d_ws, size_t ws_size, hipStream_t stream) {
    static int grid = 0;
    if (grid == 0) {
        if (n_in != 17 || in_sizes[0] != M * DM || out_size != M * DM || ws_size < WS_END) {
            fprintf(stderr, "kernel_launch: shape mismatch (n_in %d, in0 %d, out %d, ws %zu; need ws >= %zu); nothing launched\n", n_in, n_in > 0 ? in_sizes[0] : -1, out_size, ws_size, (size_t)WS_END); grid = -1; return; }
        int dev = 0, cus = 0, per_cu = 0;
        if (hipGetDevice(&dev) != hipSuccess || hipDeviceGetAttribute(&cus, hipDeviceAttributeMultiprocessorCount, dev) != hipSuccess) { grid = -1; return; }
        if (hipFuncSetAttribute((const void*)mk_fwd, hipFuncAttributeMaxDynamicSharedMemorySize, LDS_BYTES) != hipSuccess) { fprintf(stderr, "kernel_launch: hipFuncSetAttribute failed\n"); grid = -1; return; }
        if (hipOccupancyMaxActiveBlocksPerMultiprocessor(&per_cu, (const void*)mk_fwd, 512, LDS_BYTES) != hipSuccess || per_cu < 1) { fprintf(stderr, "kernel_launch: occupancy query says %d blocks per CU\n", per_cu); }
        (void)hipGetLastError();
        grid = cus > 0 ? cus : 256;
    }
    if (grid < 0) return;
    (void)hipMemsetAsync((char*)d_ws + WS_CTL, 0, CTL_ZERO_BYTES, stream);
    Args a{};
    for (int i = 0; i < 17; ++i) a.in[i] = d_in[i];
    a.out = (float*)d_out; a.ws = (unsigned char*)d_ws;
#if MK_PER_PHASE
    for (int k = 0; k < N_PHASES; ++k) { a.ph_lo = k; a.ph_hi = k + 1; hipLaunchKernelGGL(mk_fwd, dim3(grid), dim3(512), LDS_BYTES, stream, a); }
#else
#if DBG
    a.ph_lo = 0; a.ph_hi = DBG_HI; hipLaunchKernelGGL(mk_fwd, dim3(grid), dim3(512), LDS_BYTES, stream, a);
    hipLaunchKernelGGL(dbg_kernel, dim3(1024), dim3(256), 0, stream, a, DBG);
    if (DBG_HI < N_PHASES) { (void)hipMemsetAsync((char*)d_ws + WS_CTL + CW_BAR * 4, 0, XCD_BAR_WORDS * 4, stream); a.ph_lo = DBG_HI; a.ph_hi = N_PHASES; hipLaunchKernelGGL(mk_fwd, dim3(grid), dim3(512), LDS_BYTES, stream, a); }
    hipLaunchKernelGGL(dbg_apply, dim3(1024), dim3(256), 0, stream, (float*)d_out, (const unsigned*)((char*)d_ws + WS_CTL) + DBG_ERRW, (size_t)M * DM);
#else
    a.ph_lo = 0; a.ph_hi = N_PHASES; hipLaunchKernelGGL(mk_fwd, dim3(grid), dim3(512), LDS_BYTES, stream, a);
#endif
#endif
    const hipError_t le = hipPeekAtLastError();
    if (le != hipSuccess) fprintf(stderr, "kernel_launch: launch failed: %s\n", hipGetErrorName(le));
}
```
